# Optimizing an MI355X kernel written in HIP

```python
import jax, jax.numpy as jnp
from jax import lax
import numpy as np

D_MODEL = 1024
BATCH = 4
SEQ = 4096
DEPTH = 2

GRID_W = 64
CTX_LEN = 256
N_MIXERS = 2
N_SUB = 3
N_MOD = 3
D_FF = 2816
RMS_EPS = 1e-6
D_RNN = 1024
RG_BLOCKS = 8
RG_BW = D_RNN // RG_BLOCKS
CONV_W = 4
CONV_PAD_L = 2
CONV_PAD_R = CONV_W - 1 - CONV_PAD_L
RG_C = 8.0
MLA_HEADS = 8
Q_LORA = 512
KV_LORA = 256
NOPE = 128
ROPE = 64
V_DIM = 128
ROPE_BASE = 10000.0
Q_BLOCK = 128
ATTN_SCALE = (NOPE + ROPE) ** -0.5

kernel_name = "hybrid_rglru_mla_macaron_dit"


def rms_norm(x, g):
    xf = x.astype(jnp.float32)
    y = xf * lax.rsqrt(jnp.mean(xf * xf, axis=-1, keepdims=True) + RMS_EPS)
    return (y * g.astype(jnp.float32)).astype(x.dtype)


def modulate_in(x, g, m):
    return rms_norm(x, g) * (1 + m[:, None, 1]) + m[:, None, 0]


def gated_residual(x, y, g, m, weight):
    return x + weight * m[:, None, 2] * rms_norm(y, g)


def swiglu(h, w_in, w_out):
    a, b = jnp.split(h @ w_in, 2, axis=-1)
    return (jax.nn.silu(a) * b) @ w_out


def half_ffn_sublayer(x, m, g_pre, g_post, w_in, w_out):
    return gated_residual(x, swiglu(modulate_in(x, g_pre, m), w_in, w_out), g_post, m, 0.5)


def centred_dwconv(u, w, b):
    L = u.shape[1]
    up = jnp.pad(u, ((0, 0), (CONV_PAD_L, CONV_PAD_R), (0, 0)))
    out = b
    for k in range(CONV_W):
        out = out + up[:, k:k + L] * w[k]
    return out


def rglru_coeffs(u, gate_w, gate_b, lam):
    B, L, _ = u.shape
    ub = u.reshape(B, L, RG_BLOCKS, RG_BW)
    g = jnp.einsum("blnj,gnjk->gblnk", ub, gate_w.astype(jnp.float32)).reshape(2, B, L, D_RNN)
    g = jax.nn.sigmoid(g + gate_b.astype(jnp.float32)[:, None, None, :])
    r, i = g[0], g[1]
    log_a = -RG_C * r * jax.nn.softplus(-lam.astype(jnp.float32))
    a = jnp.exp(log_a)
    return a, jnp.sqrt(-jnp.expm1(2.0 * log_a)) * (i * u)


def linear_scan(a, b, h0, reverse):
    first = a.shape[1] - 1 if reverse else 0
    b = b.at[:, first].add(a[:, first] * h0)

    def combine(e1, e2):
        a1, b1 = e1
        a2, b2 = e2
        return a1 * a2, a2 * b1 + b2

    _, h = lax.associative_scan(combine, (a, b), reverse=reverse, axis=1)
    return h


def rglru_mixer(hc, hl, params, need_ctx):
    w_in, conv_w, conv_b, gate_w, gate_b, lam, w_out = params

    def branches(h):
        y, u = jnp.split(h @ w_in, 2, axis=-1)
        return jax.nn.gelu(y), centred_dwconv(u, conv_w, conv_b).astype(jnp.float32)

    yc, uc = branches(hc)
    yl, ul = branches(hl)
    h0 = jnp.zeros((hc.shape[0], D_RNN), jnp.float32)
    ctx_dirs, lat_dirs = [], []
    for d, reverse in enumerate((False, True)):
        a_c, b_c = rglru_coeffs(uc, gate_w[d], gate_b[d], lam[d])
        h_c = linear_scan(a_c, b_c, h0, reverse)
        h_last = h_c[:, 0] if reverse else h_c[:, -1]
        a_l, b_l = rglru_coeffs(ul, gate_w[d], gate_b[d], lam[d])
        lat_dirs.append(linear_scan(a_l, b_l, h_last, reverse))
        ctx_dirs.append(h_c)
    out_l = ((lat_dirs[0] + lat_dirs[1]).astype(hl.dtype) * yl) @ w_out
    out_c = None
    if need_ctx:
        out_c = ((ctx_dirs[0] + ctx_dirs[1]).astype(hc.dtype) * yc) @ w_out
    return out_c, out_l


def axial_rope(t, rows, cols):
    half = ROPE // 2
    quarter = half // 2
    inv_freq = ROPE_BASE ** (-jnp.arange(quarter, dtype=jnp.float32) / quarter)
    tf = t.astype(jnp.float32)
    bshape = (1, t.shape[1]) + (1,) * (t.ndim - 3) + (quarter,)

    def rot(v, pos):
        ang = (pos.astype(jnp.float32)[:, None] * inv_freq).reshape(bshape)
        cos, sin = jnp.cos(ang), jnp.sin(ang)
        v1, v2 = v[..., :quarter], v[..., quarter:]
        return jnp.concatenate([v1 * cos - v2 * sin, v1 * sin + v2 * cos], axis=-1)

    return jnp.concatenate([rot(tf[..., :half], rows), rot(tf[..., half:], cols)], axis=-1).astype(t.dtype)


def mla_project(h, w_a, q_norm, kv_norm, w_qb, w_kvb):
    B, L, _ = h.shape
    c_q, c_kv, k_rope = jnp.split(h @ w_a, [Q_LORA, Q_LORA + KV_LORA], axis=-1)
    q = (rms_norm(c_q, q_norm) @ w_qb).reshape(B, L, MLA_HEADS, NOPE + ROPE)
    kv = (rms_norm(c_kv, kv_norm) @ w_kvb).reshape(B, L, MLA_HEADS, NOPE + V_DIM)
    return q[..., :NOPE], q[..., NOPE:], kv[..., :NOPE], k_rope, kv[..., NOPE:]


def mla_attention(q_nope, q_rope, k_nope, k_rope, v):
    B, L, H, _ = q_nope.shape
    nb = L // Q_BLOCK

    def to_blocks(q):
        return q.reshape(B, nb, Q_BLOCK, H, q.shape[-1]).swapaxes(0, 1)

    def attend(blk):
        qn, qr = blk
        s = (jnp.einsum("bqhd,bkhd->bhqk", qn, k_nope, preferred_element_type=jnp.float32)
             + jnp.einsum("bqhr,bkr->bhqk", qr, k_rope, preferred_element_type=jnp.float32)) * ATTN_SCALE
        p = jax.nn.softmax(s, axis=-1).astype(v.dtype)
        return jnp.einsum("bhqk,bkhd->bqhd", p, v)

    o = lax.map(attend, (to_blocks(q_nope), to_blocks(q_rope)))
    return o.swapaxes(0, 1).reshape(B, L, H * V_DIM)


def mla_mixer(hc, hl, params, need_ctx):
    w_a, q_norm, kv_norm, w_qb, w_kvb, w_o = params
    L = hl.shape[1]
    n_rows = L // GRID_W
    rows = jnp.repeat(jnp.arange(n_rows, dtype=jnp.int32), GRID_W)
    cols = jnp.tile(jnp.arange(GRID_W, dtype=jnp.int32), n_rows)
    qn_l, qr_l, kn_l, kr_l, v_l = mla_project(hl, w_a, q_norm, kv_norm, w_qb, w_kvb)
    qr_l = axial_rope(qr_l, rows, cols)
    kr_l = axial_rope(kr_l, rows, cols)
    qn_c, qr_c, kn_c, kr_c, v_c = mla_project(hc, w_a, q_norm, kv_norm, w_qb, w_kvb)
    out_l = mla_attention(qn_l, qr_l,
                          jnp.concatenate([kn_c, kn_l], axis=1),
                          jnp.concatenate([kr_c, kr_l], axis=1),
                          jnp.concatenate([v_c, v_l], axis=1)) @ w_o
    out_c = None
    if need_ctx:
        out_c = mla_attention(qn_c, qr_c, kn_c, kr_c, v_c) @ w_o
    return out_c, out_l


def hybrid_layer(xc, xl, mod_c, mod_l, norm_g, ffn_w_in, ffn_w_out, mixer, mixer_params, last):
    xc = half_ffn_sublayer(xc, mod_c[:, 0], norm_g[0], norm_g[1], ffn_w_in[0], ffn_w_out[0])
    xl = half_ffn_sublayer(xl, mod_l[:, 0], norm_g[0], norm_g[1], ffn_w_in[0], ffn_w_out[0])
    out_c, out_l = mixer(modulate_in(xc, norm_g[2], mod_c[:, 1]),
                         modulate_in(xl, norm_g[2], mod_l[:, 1]), mixer_params, not last)
    xl = gated_residual(xl, out_l, norm_g[3], mod_l[:, 1], 1.0)
    xl = half_ffn_sublayer(xl, mod_l[:, 2], norm_g[4], norm_g[5], ffn_w_in[1], ffn_w_out[1])
    if not last:
        xc = gated_residual(xc, out_c, norm_g[3], mod_c[:, 1], 1.0)
        xc = half_ffn_sublayer(xc, mod_c[:, 2], norm_g[4], norm_g[5], ffn_w_in[1], ffn_w_out[1])
    return xc, xl


def setup_inputs(seed: int = 0) -> dict:
    key = jax.random.key(seed)
    ks = iter(jax.random.split(key, 64))

    def nrm(shape, scale):
        return jax.random.normal(next(ks), shape, jnp.float32) * scale

    d = D_MODEL
    inp = {
        "x": nrm((BATCH, SEQ, d), 1.0),
        "c": nrm((BATCH, d), 1.0),
        "ctx": nrm((BATCH, CTX_LEN, d), 1.0),
        "c_ctx": nrm((d,), 1.0),
    }
    for i in range(DEPTH):
        p = "l%d_" % i
        inp[p + "mod_w"] = nrm((d, N_SUB * N_MOD * d), 0.5 * d ** -0.5)
        inp[p + "mod_b"] = nrm((N_SUB * N_MOD * d,), 0.02)
        inp[p + "norm_g"] = 1.0 + nrm((2 * N_SUB, d), 0.05)
        inp[p + "ffn_w_in"] = nrm((2, d, 2 * D_FF), d ** -0.5)
        inp[p + "ffn_w_out"] = nrm((2, D_FF, d), D_FF ** -0.5)
        if i % N_MIXERS == 0:
            inp[p + "rg_w_in"] = nrm((d, 2 * D_RNN), d ** -0.5)
            inp[p + "rg_conv_w"] = nrm((CONV_W, D_RNN), CONV_W ** -0.5)
            inp[p + "rg_conv_b"] = nrm((D_RNN,), 0.02)
            inp[p + "rg_gate_w"] = nrm((2, 2, RG_BLOCKS, RG_BW, RG_BW), RG_BW ** -0.5)
            inp[p + "rg_gate_b"] = nrm((2, 2, D_RNN), 0.1)
            a_c = jax.random.uniform(next(ks), (2, D_RNN), jnp.float32, minval=0.9, maxval=0.999)
            a0 = a_c ** (1.0 / RG_C)
            inp[p + "rg_lambda"] = jnp.log(a0) - jnp.log1p(-a0)
            inp[p + "rg_w_out"] = nrm((D_RNN, d), D_RNN ** -0.5)
        else:
            inp[p + "mla_w_a"] = nrm((d, Q_LORA + KV_LORA + ROPE), d ** -0.5)
            inp[p + "mla_q_norm"] = 1.0 + nrm((Q_LORA,), 0.05)
            inp[p + "mla_kv_norm"] = 1.0 + nrm((KV_LORA,), 0.05)
            inp[p + "mla_w_qb"] = nrm((Q_LORA, MLA_HEADS * (NOPE + ROPE)), Q_LORA ** -0.5)
            inp[p + "mla_w_kvb"] = nrm((KV_LORA, MLA_HEADS * (NOPE + V_DIM)), KV_LORA ** -0.5)
            inp[p + "mla_w_o"] = nrm((MLA_HEADS * V_DIM, d), (MLA_HEADS * V_DIM) ** -0.5)
    return inp


def reference(x, c, ctx, c_ctx,
              l0_mod_w, l0_mod_b, l0_norm_g, l0_ffn_w_in, l0_ffn_w_out,
              l0_rg_w_in, l0_rg_conv_w, l0_rg_conv_b, l0_rg_gate_w, l0_rg_gate_b, l0_rg_lambda, l0_rg_w_out,
              l1_mod_w, l1_mod_b, l1_norm_g, l1_ffn_w_in, l1_ffn_w_out,
              l1_mla_w_a, l1_mla_q_norm, l1_mla_kv_norm, l1_mla_w_qb, l1_mla_w_kvb, l1_mla_w_o):
    layers = (
        (l0_mod_w, l0_mod_b, l0_norm_g, l0_ffn_w_in, l0_ffn_w_out,
         (l0_rg_w_in, l0_rg_conv_w, l0_rg_conv_b, l0_rg_gate_w, l0_rg_gate_b, l0_rg_lambda, l0_rg_w_out)),
        (l1_mod_w, l1_mod_b, l1_norm_g, l1_ffn_w_in, l1_ffn_w_out,
         (l1_mla_w_a, l1_mla_q_norm, l1_mla_kv_norm, l1_mla_w_qb, l1_mla_w_kvb, l1_mla_w_o)),
    )
    mixers = (rglru_mixer, mla_mixer)
    xc, xl = ctx, x
    for i in range(DEPTH):
        mod_w, mod_b, norm_g, ffn_w_in, ffn_w_out, mixer_params = layers[i]
        mod_l = (jax.nn.silu(c) @ mod_w + mod_b).reshape(c.shape[0], N_SUB, N_MOD, -1)
        mod_c = (jax.nn.silu(c_ctx) @ mod_w + mod_b).reshape(1, N_SUB, N_MOD, -1)
        xc, xl = hybrid_layer(xc, xl, mod_c, mod_l, norm_g, ffn_w_in, ffn_w_out,
                              mixers[i % N_MIXERS], mixer_params, i == DEPTH - 1)
    return xl
```

```cpp
#include <hip/hip_runtime.h>
#include <hip/hip_cooperative_groups.h>
#include <hip/hip_fp16.h>
#include <cstdio>
namespace cg = cooperative_groups;
__device__ __forceinline__ int tid_l() { int t = threadIdx.x; asm volatile("" : "+v"(t)); return t; }
__device__ __forceinline__ int bid_l() { int b = blockIdx.x; asm volatile("" : "+s"(b)); return b; }
namespace pg8 {
#define PG8_LAS __attribute__((address_space(3)))
typedef unsigned short bf16_t;
typedef short bf16x8 __attribute__((ext_vector_type(8)));
typedef float f32x4 __attribute__((ext_vector_type(4)));
typedef unsigned u32x4 __attribute__((ext_vector_type(4)));
constexpr int BM = 256, BK = 64, HALF = 128, HTB = HALF * BK * 2  , STAGE_BYTES = 8 * HTB, NXCD = 8, WGM = 8;

__host__ __device__ __forceinline__ int lds_byte(int r, int c) { const int st = (r >> 4) * 2 + (c >> 5), rr = r & 15, cc = c & 31, ob = rr * 64 + cc * 2; return st * 1024 + (ob ^ (((ob >> 9) & 1) << 5)); }
__host__ __device__ __forceinline__ void stage_rc(int b, int& R, int& C) { const int st = b / 1024, sb = b % 1024, swz = sb ^ (((sb >> 9) & 1) << 5); R = (st >> 1) * 16 + swz / 64; C = (st & 1) * 32 + (swz % 64) / 2; }
__host__ __device__ __forceinline__ int perm32(int rho) { const int n = rho >> 4, i = rho & 15; return 8 * (i >> 2) + 4 * n + (i & 3); }

struct Unit { int pm, pn; };
struct Gemm { const bf16_t* A; const bf16_t* Bt; int M, N, K, lda, ldb, agrp; };

struct StaticOrder {
    int nM, nN, nwg, G, c;
    __host__ __device__ void init(int M, int N, int G_, int c_) { nM = M / BM; nN = N / BM; nwg = nM * nN; G = G_; c = c_; }
    __host__ __device__ bool next(int i, Unit& u) const {
        const long L = (long)i * G + c; if (L >= nwg) return false;
        int wgid = (int)L; { const int q = nwg / NXCD, r = nwg % NXCD, xcd = wgid % NXCD, off = wgid / NXCD; wgid = (xcd < r ? xcd * (q + 1) : r * (q + 1) + (xcd - r) * q) + off; }
        const int nig = WGM * nN, gid = wgid / nig, fm = gid * WGM, gsz = (nM - fm) < WGM ? (nM - fm) : WGM;
        u.pm = fm + ((wgid % nig) % gsz); u.pn = (wgid % nig) / gsz; return true;
    }
    __device__ __forceinline__ void a_ready(const Unit&) const {}
    __device__ __forceinline__ void done(const Unit&) const {}
};
template <class Epi, class Sched, bool STAMP = false>
__device__ __forceinline__ void gemm_phase(PG8_LAS unsigned char* lds, const Gemm g, const Sched& S, const Epi& E, unsigned long long* stamps) {
    const int tid = tid_l(), wid = __builtin_amdgcn_readfirstlane(tid >> 6), lane = tid & 63, wr = wid >> 2, wc = wid & 3, fr = lane & 15, fq = lane >> 4;
    const int K = g.K, nt = K / BK;
    unsigned voffA[2], voffB[2];
#pragma unroll
    for (int i = 0; i < 2; ++i) { int R, C; stage_rc(tid * 16 + i * 8192, R, C); const int Rb = Epi::PERM ? ((R & ~31) + perm32(R & 31)) : R;
        voffA[i] = (unsigned)(R * g.lda + C) * 2u; voffB[i] = (unsigned)(Rb * g.ldb + C) * 2u; }
    const size_t kstep = (size_t)(BK * 2);
    const size_t hstepA = (size_t)HALF * g.lda * 2, hstepB = (size_t)HALF * g.ldb * 2;
    const size_t tstepA = 2 * hstepA, tstepB = 2 * hstepB;
    const unsigned ldsw = (unsigned)wid * 1024u;
    const int aoff = lds_byte(wr * 64 + fr, fq * 8), boff = lds_byte(wc * 32 + fr, fq * 8);
#define PG8_SA(b, h) (((b) * 2 + (h)) * HTB)
#define PG8_SB(b, h) ((4 + (b) * 2 + (h)) * HTB)
#define PG8_STAGE(bufoff, gbase, voff) do { _Pragma("unroll") for (int _i = 0; _i < 2; ++_i) \
        __builtin_amdgcn_global_load_lds((const unsigned*)((const char*)(gbase) + (voff)[_i]), (PG8_LAS unsigned*)(lds + (bufoff) + ldsw + _i * 8192), 16, 0, 0); } while (0)
#define PG8_LDA(dst, b, h) do { _Pragma("unroll") for (int m = 0; m < 4; ++m) _Pragma("unroll") for (int k = 0; k < 2; ++k) dst[m][k] = *(const PG8_LAS bf16x8*)(lds + PG8_SA(b, h) + aoff + m * 2048 + k * 1024); } while (0)
#define PG8_LDB(dst, b, h) do { _Pragma("unroll") for (int n = 0; n < 2; ++n) _Pragma("unroll") for (int k = 0; k < 2; ++k) dst[n][k] = *(const PG8_LAS bf16x8*)(lds + PG8_SB(b, h) + boff + n * 2048 + k * 1024); } while (0)
#define PG8_MMA(ai, bj, At, Bt) do { __builtin_amdgcn_s_setprio(1); _Pragma("unroll") for (int m = 0; m < 4; ++m) _Pragma("unroll") for (int n = 0; n < 2; ++n) _Pragma("unroll") for (int k = 0; k < 2; ++k) \
        acc[ai][bj][m][n] = __builtin_amdgcn_mfma_f32_16x16x32_bf16(Bt[n][k], At[m][k], acc[ai][bj][m][n], 0, 0, 0); __builtin_amdgcn_s_setprio(0); } while (0)
#define PG8_WAIT_V(n) asm volatile("s_waitcnt vmcnt(" #n ")" ::: "memory")
#define PG8_WAIT_L(n) asm volatile("s_waitcnt lgkmcnt(" #n ")" ::: "memory")
#define PG8_BAR __builtin_amdgcn_s_barrier()
#define PG8_SCHED __builtin_amdgcn_sched_barrier(0)
    Unit cur, nxt; int ui = 0;
    if (!S.next(0, cur)) return;
    f32x4 acc[2][2][4][2];
#pragma unroll
    for (int a = 0; a < 2; ++a)
#pragma unroll
        for (int b = 0; b < 2; ++b)
#pragma unroll
            for (int m = 0; m < 4; ++m)
#pragma unroll
                for (int n = 0; n < 2; ++n) acc[a][b][m][n] = (f32x4){0.f, 0.f, 0.f, 0.f};
    bf16x8 At[4][2], B0[2][2], B1[2][2];
    const char* cA = (const char*)g.A + (size_t)cur.pm * tstepA + (size_t)(cur.pn / g.agrp) * K * 2; const char* cB = (const char*)g.Bt + (size_t)cur.pn * tstepB;
    S.a_ready(cur);
    PG8_STAGE(PG8_SB(0, 0), cB, voffB); PG8_STAGE(PG8_SA(0, 0), cA, voffA); PG8_STAGE(PG8_SB(0, 1), cB + hstepB, voffB); PG8_STAGE(PG8_SA(0, 1), cA + hstepA, voffA);
    if (wr == 1) PG8_BAR;
    PG8_WAIT_V(4); PG8_BAR;
    PG8_STAGE(PG8_SB(1, 0), cB + kstep, voffB); PG8_STAGE(PG8_SA(1, 0), cA + kstep, voffA); PG8_STAGE(PG8_SB(1, 1), cB + hstepB + kstep, voffB);
    PG8_WAIT_V(6); PG8_BAR;
    for (;;) {
        const bool has_next = S.next(ui + 1, nxt);
        const char* nA = has_next ? (const char*)g.A + (size_t)nxt.pm * tstepA + (size_t)(nxt.pn / g.agrp) * K * 2 : cA; const char* nB = has_next ? (const char*)g.Bt + (size_t)nxt.pn * tstepB : cB;
        for (int t = 0; t < nt; t += 2) {
            const bool last = (t == nt - 2);
            const char* a1 = cA + (size_t)(t + 1) * kstep;
            const char* a2 = last ? nA : cA + (size_t)(t + 2) * kstep; const char* b2 = last ? nB : cB + (size_t)(t + 2) * kstep;
            const char* a3 = a2 + kstep; const char* b3 = b2 + kstep;
            if (last && has_next) S.a_ready(nxt);
            PG8_LDB(B0, 0, 0); PG8_SCHED; PG8_LDA(At, 0, 0); PG8_STAGE(PG8_SA(1, 1), a1 + hstepA, voffA);
            PG8_WAIT_L(8); PG8_BAR; PG8_WAIT_L(0); PG8_MMA(0, 0, At, B0); PG8_BAR; PG8_SCHED;
            PG8_LDB(B1, 0, 1); PG8_STAGE(PG8_SB(0, 0), b2, voffB);
            PG8_BAR; PG8_WAIT_L(0); PG8_MMA(0, 1, At, B1); PG8_BAR;
            PG8_LDA(At, 0, 1); PG8_STAGE(PG8_SA(0, 0), a2, voffA);
            PG8_BAR; PG8_WAIT_L(0); PG8_MMA(1, 0, At, B0); PG8_BAR; PG8_SCHED;
            PG8_STAGE(PG8_SB(0, 1), b2 + hstepB, voffB);
            PG8_WAIT_V(6); PG8_BAR; PG8_MMA(1, 1, At, B1); PG8_BAR;
            PG8_LDB(B0, 1, 0); PG8_SCHED; PG8_LDA(At, 1, 0); PG8_STAGE(PG8_SA(0, 1), a2 + hstepA, voffA);
            PG8_WAIT_L(8); PG8_BAR; PG8_WAIT_L(0); PG8_MMA(0, 0, At, B0); PG8_BAR; PG8_SCHED;
            PG8_LDB(B1, 1, 1); PG8_STAGE(PG8_SB(1, 0), b3, voffB);
            PG8_BAR; PG8_WAIT_L(0); PG8_MMA(0, 1, At, B1); PG8_BAR;
            PG8_LDA(At, 1, 1); PG8_STAGE(PG8_SA(1, 0), a3, voffA);
            PG8_BAR; PG8_WAIT_L(0); PG8_MMA(1, 0, At, B0); PG8_BAR; PG8_SCHED;
            PG8_STAGE(PG8_SB(1, 1), b3 + hstepB, voffB);
            PG8_WAIT_V(6); PG8_BAR; PG8_MMA(1, 1, At, B1); PG8_BAR;
        }
        if constexpr (!Epi::AFTER_DRAIN) { E(acc, cur, wr, wc, fr, fq); S.done(cur); }
        if (!has_next) break;
#pragma unroll
        for (int a = 0; a < 2; ++a)
#pragma unroll
            for (int b = 0; b < 2; ++b)
#pragma unroll
                for (int m = 0; m < 4; ++m)
#pragma unroll
                    for (int n = 0; n < 2; ++n) acc[a][b][m][n] = (f32x4){0.f, 0.f, 0.f, 0.f};
        cur = nxt; cA = nA; cB = nB; ++ui;
    }
    PG8_WAIT_V(0);
    if (wr == 0) PG8_BAR;
    PG8_BAR;
    if constexpr (Epi::AFTER_DRAIN) { E.fused(acc, cur, wr, wc, fr, fq, lds, wid, lane); S.done(cur); }
#undef PG8_SA
#undef PG8_SB
#undef PG8_STAGE
#undef PG8_LDA
#undef PG8_LDB
#undef PG8_MMA
#undef PG8_WAIT_V
#undef PG8_WAIT_L
#undef PG8_BAR
#undef PG8_SCHED
}
}
#define DI __device__ __forceinline__
#define LAS __attribute__((address_space(3)))
using pg8::bf16_t; using pg8::bf16x8; using pg8::f32x4; using pg8::u32x4; using pg8::Unit;
typedef float f32x2 __attribute__((ext_vector_type(2)));
typedef float f32x16 __attribute__((ext_vector_type(16)));
typedef unsigned u32x2 __attribute__((ext_vector_type(2)));
typedef __bf16 bf2_t __attribute__((ext_vector_type(2)));
constexpr int DM = 1024, ML = 16384, MC = 1024, MT = ML + MC, DFF = 2816, NKEY = 4352, NCH = 68;
constexpr size_t MiB = 1048576;
constexpr size_t OFF_MOD = 0, OFF_ROPE = MiB / 2, OFF_CAR = 1 * MiB, OFF_XC = 6 * MiB;
constexpr size_t OFF_WIN0 = 10 * MiB, OFF_WOUT0 = 32 * MiB, OFF_RGIN = 43 * MiB, OFF_RGOUT = 47 * MiB, OFF_GATE = 49 * MiB;
constexpr size_t SZ_WIN = (size_t)5632 * 1024 * 2, SZ_WOUT = (size_t)1024 * 2816 * 2;
constexpr size_t OFF_R0 = 52 * MiB, OFF_R1 = 86 * MiB, OFF_R2 = 120 * MiB;
constexpr size_t OFF_XN = OFF_R0, OFF_UC = OFF_R0, OFF_Y = OFF_R0, OFF_VT = OFF_R0;
constexpr size_t OFF_H = OFF_R1, OFF_YG = OFF_R1, OFF_CA = OFF_R1, OFF_O = OFF_R1;
constexpr size_t OFF_U = OFF_R2, OFF_AB0 = 120 * MiB, OFF_AB1 = 188 * MiB;
constexpr size_t OFF_WIN1 = 180 * MiB, OFF_WOUT1 = 202 * MiB, OFF_WA = 213 * MiB, OFF_WQB = 215 * MiB, OFF_WKN = 216 * MiB + MiB / 2, OFF_WV = 217 * MiB, OFF_WO = 217 * MiB + MiB / 2;
constexpr size_t OFF_Q = 120 * MiB, OFF_CKV = 168 * MiB, OFF_KR = 177 * MiB, OFF_KN = 220 * MiB, OFF_CQ = 256 * MiB, WS_TOTAL = 272 * MiB;
constexpr int LDS_BYTES = 131072;
constexpr float QSCALE = 0.07216878364870322f * 1.4426950408889634f;

constexpr size_t OFF_TAB = MiB / 2 + 65536;
struct Params {
    const float* inp[27]; float* out; unsigned char* ws; int ph_lo, ph_hi;
    DI const float* in(int i) const { return inp[i]; }
};
struct Ctx {
    unsigned char* ws; float* out; const float* const* tab;
    DI const float* in(int i) const { return tab[i]; }
};
enum { I_X = 0, I_C, I_CTX, I_CCTX, I_MODW0, I_MODB0, I_NORMG0, I_FIN0, I_FOUT0, I_RGIN, I_CONVW, I_CONVB, I_GATEW, I_GATEB, I_LAM, I_RGOUT, I_MODW1, I_MODB1, I_NORMG1, I_FIN1, I_FOUT1, I_WA, I_QNORM, I_KVNORM, I_WQB, I_WKVB, I_WO };
DI unsigned pk2(float a, float b) { f32x2 v = {a, b}; return __builtin_bit_cast(unsigned, __builtin_convertvector(v, bf2_t)); }
DI float bflo(unsigned u) { return __uint_as_float(u << 16); }
DI float bfhi(unsigned u) { return __uint_as_float(u & 0xffff0000u); }
DI float bf1(bf16_t v) { return __uint_as_float(((unsigned)v) << 16); }
DI float wave_sum(float v) {
#pragma unroll
    for (int o = 32; o; o >>= 1) v += __shfl_xor(v, o);
    return v; }
DI float sigm(float x) { return 1.f / (1.f + __expf(-x)); }
DI int rope_orig(int p) { const int pid = 4 * (p >> 3) + (p & 3), s = (p >> 2) & 1; return (pid >> 4) * 32 + s * 16 + (pid & 15); }

struct EpiStore {
    static constexpr bool PERM = true, AFTER_DRAIN = false;
    bf16_t* O; int ldo;
    DI void operator()(const f32x4 (&acc)[2][2][4][2], const Unit& u, int wr, int wc, int fr, int fq) const {
        const int row0 = u.pm * 256 + wr * 64 + fr, col0 = u.pn * 256 + wc * 32 + 8 * fq;
#pragma unroll
        for (int ai = 0; ai < 2; ++ai)
#pragma unroll
            for (int m = 0; m < 4; ++m) { bf16_t* rowp = O + (size_t)(row0 + ai * 128 + m * 16) * ldo + col0;
#pragma unroll
                for (int bj = 0; bj < 2; ++bj) { const f32x4 v0 = acc[ai][bj][m][0], v1 = acc[ai][bj][m][1];
                    *(u32x4*)(rowp + bj * 128) = (u32x4){pk2(v0[0], v0[1]), pk2(v0[2], v0[3]), pk2(v1[0], v1[1]), pk2(v1[2], v1[3])}; } }
    }
};
struct EpiSwiglu {
    static constexpr bool PERM = true, AFTER_DRAIN = false;
    bf16_t* H;
    DI void operator()(const f32x4 (&acc)[2][2][4][2], const Unit& u, int wr, int wc, int fr, int fq) const {
        const int row0 = u.pm * 256 + wr * 64 + fr, col0 = u.pn * 128 + wc * 32 + 8 * fq;
#pragma unroll
        for (int ai = 0; ai < 2; ++ai)
#pragma unroll
            for (int m = 0; m < 4; ++m) { float h[8];
#pragma unroll
                for (int n = 0; n < 2; ++n)
#pragma unroll
                    for (int i = 0; i < 4; ++i) { const float a = acc[ai][0][m][n][i], b = acc[ai][1][m][n][i]; h[n * 4 + i] = a * sigm(a) * b; }
                *(u32x4*)(H + (size_t)(row0 + ai * 128 + m * 16) * DFF + col0) = (u32x4){pk2(h[0], h[1]), pk2(h[2], h[3]), pk2(h[4], h[5]), pk2(h[6], h[7])}; }
    }
};
DI float gelu_tanh(float x) { const float z = 0.7978845608028654f * (x + 0.044715f * x * x * x); return x * sigm(2.f * z); }
struct EpiRgIn {
    static constexpr bool PERM = true, AFTER_DRAIN = false;
    bf16_t* YG; bf16_t* U;
    DI void operator()(const f32x4 (&acc)[2][2][4][2], const Unit& u, int wr, int wc, int fr, int fq) const {
        const int row0 = u.pm * 256 + wr * 64 + fr, col0 = (u.pn & 3) * 256 + wc * 32 + 8 * fq; const bool isy = u.pn < 4; bf16_t* dst = isy ? YG : U;
#pragma unroll
        for (int ai = 0; ai < 2; ++ai)
#pragma unroll
            for (int m = 0; m < 4; ++m) { bf16_t* rowp = dst + (size_t)(row0 + ai * 128 + m * 16) * DM + col0;
#pragma unroll
                for (int bj = 0; bj < 2; ++bj) { f32x4 v0 = acc[ai][bj][m][0], v1 = acc[ai][bj][m][1];
                    if (isy) {
#pragma unroll
                        for (int i = 0; i < 4; ++i) { v0[i] = gelu_tanh(v0[i]); v1[i] = gelu_tanh(v1[i]); } }
                    *(u32x4*)(rowp + bj * 128) = (u32x4){pk2(v0[0], v0[1]), pk2(v0[2], v0[3]), pk2(v1[0], v1[1]), pk2(v1[2], v1[3])}; } }
    }
};
DI float neg_expm1(float x) {
    const float pl = -x * (1.f + x * 0.5f * (1.f + x * (1.f / 3.f) * (1.f + x * 0.25f * (1.f + x * 0.2f * (1.f + x * (1.f / 6.f))))));
    return x < -0.25f ? 1.f - __expf(x) : pl; }
DI float log1p_small(float e) {
    const float pl = e * (1.f - e * (0.5f - e * ((1.f / 3.f) - e * (0.25f - e * 0.2f))));
    return e > 0.03f ? __logf(1.f + e) : pl; }
struct EpiGate {
    static constexpr bool PERM = false, AFTER_DRAIN = false;
    const bf16_t* UC; const float* gate_b; const float* lam; __half2* AB0; __half2* AB1;
    DI void operator()(const f32x4 (&acc)[2][2][4][2], const Unit& u, int wr, int wc, int fr, int fq) const {
        const int j2 = u.pn >> 2, d = (u.pn >> 1) & 1, half = u.pn & 1;
        const int row0 = u.pm * 256 + wr * 64 + fr, ch0 = j2 * 256 + half * 128 + wc * 32 + 4 * fq;
        __half2* AB = d ? AB1 : AB0;
#pragma unroll
        for (int n = 0; n < 2; ++n) { const int ch = ch0 + 16 * n;
            const f32x4 gr = *(const f32x4*)(gate_b + (d * 2 + 0) * DM + ch), gi = *(const f32x4*)(gate_b + (d * 2 + 1) * DM + ch), l = *(const f32x4*)(lam + d * DM + ch);
            f32x4 c8;
#pragma unroll
            for (int i = 0; i < 4; ++i) c8[i] = -8.f * log1p_small(__expf(-l[i]));
#pragma unroll
            for (int ai = 0; ai < 2; ++ai)
#pragma unroll
                for (int m = 0; m < 4; ++m) { const size_t rowoff = (size_t)(row0 + ai * 128 + m * 16) * DM;
                    const u32x2 uu = *(const u32x2*)(UC + rowoff + ch); const float uv[4] = {bflo(uu[0]), bfhi(uu[0]), bflo(uu[1]), bfhi(uu[1])};
                    unsigned o[4];
#pragma unroll
                    for (int i = 0; i < 4; ++i) { const float rr = sigm(acc[ai][0][m][n][i] + gr[i]), ii = sigm(acc[ai][1][m][n][i] + gi[i]);
                        const float la = c8[i] * rr; const float bv = sqrtf(neg_expm1(2.f * la)) * ii * uv[i]; o[i] = __builtin_bit_cast(unsigned, __floats2half2_rn(la, bv)); }
                    *(u32x4*)(AB + rowoff + ch) = (u32x4){o[0], o[1], o[2], o[3]}; } }
    }
};
struct EpiQ {
    static constexpr bool PERM = true, AFTER_DRAIN = false;
    bf16_t* Q; const float* rope;
    DI void operator()(const f32x4 (&acc)[2][2][4][2], const Unit& u, int wr, int wc, int fr, int fq) const {
        const int row0 = u.pm * 256 + wr * 64 + fr;
#pragma unroll
        for (int bj = 0; bj < 2; ++bj) { const int c0 = u.pn * 256 + bj * 128 + wc * 32 + 8 * fq; const int h = c0 / 192, d0 = c0 - h * 192;
            const bool isrope = d0 >= 128; const int g = (d0 - 128) >> 3;
#pragma unroll
            for (int ai = 0; ai < 2; ++ai)
#pragma unroll
                for (int m = 0; m < 4; ++m) { const int row = row0 + ai * 128 + m * 16; f32x4 v0 = acc[ai][bj][m][0], v1 = acc[ai][bj][m][1];
                    if (isrope) { const int t = row & 4095, pos = (g >> 2) ? (t & 63) : (t >> 6);
                        const f32x4 cs0 = *(const f32x4*)(rope + (pos * 16 + 4 * (g & 3)) * 2), cs1 = *(const f32x4*)(rope + (pos * 16 + 4 * (g & 3)) * 2 + 4);
                        const float cc[4] = {cs0[0], cs0[2], cs1[0], cs1[2]}, sn[4] = {cs0[1], cs0[3], cs1[1], cs1[3]};
#pragma unroll
                        for (int i = 0; i < 4; ++i) { const float a = v0[i], b = v1[i]; v0[i] = a * cc[i] - b * sn[i]; v1[i] = a * sn[i] + b * cc[i]; } }
                    v0 *= QSCALE; v1 *= QSCALE;
                    *(u32x4*)(Q + (size_t)row * 1536 + c0) = (u32x4){pk2(v0[0], v0[1]), pk2(v0[2], v0[3]), pk2(v1[0], v1[1]), pk2(v1[2], v1[3])}; } }
    }
};
struct EpiVT {
    static constexpr bool PERM = false, AFTER_DRAIN = false;
    bf16_t* VT;
    DI void operator()(const f32x4 (&acc)[2][2][4][2], const Unit& u, int wr, int wc, int fr, int fq) const {
        const int f0 = u.pm * 256 + wr * 64 + fr;
#pragma unroll
        for (int bj = 0; bj < 2; ++bj)
#pragma unroll
            for (int n = 0; n < 2; ++n) { const int tok = u.pn * 256 + bj * 128 + wc * 32 + 16 * n + 4 * fq;
                int b, key; if (tok < ML) { b = tok >> 12; key = 256 + (tok & 4095); } else { b = (tok - ML) >> 8; key = (tok - ML) & 255; }
                const int qi = (key >> 2) & 3, pos = (key & ~15) + 4 * (((qi & 1) << 1) | (qi >> 1));
#pragma unroll
                for (int ai = 0; ai < 2; ++ai)
#pragma unroll
                    for (int m = 0; m < 4; ++m) { const int f = f0 + ai * 128 + m * 16; const f32x4 v = acc[ai][bj][m][n];
                        *(u32x2*)(VT + ((size_t)(b * 1024 + f)) * NKEY + pos) = (u32x2){pk2(v[0], v[1]), pk2(v[2], v[3])}; } }
    }
};
struct WD { const float* src; bf16_t* dst; int Np, K, kind, lds, nvalid; };
DI float wfetch(const WD& w, int n, int k) {
    int col;
    switch (w.kind) {
        case 0: col = n < w.nvalid ? n : -1; break;
        case 1: col = ((n >> 7) & 1) * DFF + (n >> 8) * 128 + (n & 127); break;
        case 3: { const int h = n / 192, d = n - h * 192; col = d < 128 ? n : h * 192 + 128 + rope_orig(d - 128); } break;
        case 4: col = (n >> 7) * 256 + (n & 127); break;
        case 5: col = (n >> 7) * 256 + 128 + (n & 127); break;
        default: { const int pn = n >> 8, bj = (n >> 7) & 1, jj = n & 127, j2 = pn >> 2, d = (pn >> 1) & 1, half = pn & 1;
            if ((k >> 7) != half) return 0.f;
            return w.src[((((d * 2 + bj) * 8 + (2 * j2 + half)) * 128 + (k & 127)) * 128) + jj]; }
    }
    return col < 0 ? 0.f : w.src[(size_t)k * w.lds + col];
}
DI void convert_weight(const WD& w, float* tile  ) {
    const int tid = tid_l(), lane = tid & 63, wv = tid >> 6;
    const int tk = w.K >> 6, ntile = (w.Np >> 6) * tk;
    for (int t = bid_l(); t < ntile; t += gridDim.x) {
        const int n0 = (t / tk) << 6, k0 = (t % tk) << 6;
#pragma unroll
        for (int i = 0; i < 8; ++i) { const int kl = i * 8 + wv; tile[kl * 65 + lane] = wfetch(w, n0 + lane, k0 + kl); }
        __syncthreads();
        { const int nl = tid >> 3, kc = tid & 7; float v[8];
#pragma unroll
          for (int j = 0; j < 8; ++j) v[j] = tile[(kc * 8 + j) * 65 + nl];
          *(u32x4*)(w.dst + (size_t)(n0 + nl) * w.K + k0 + kc * 8) = (u32x4){pk2(v[0], v[1]), pk2(v[2], v[3]), pk2(v[4], v[5]), pk2(v[6], v[7])}; }
        __syncthreads();
    }
}
DI WD mkwd(const float* src, unsigned char* ws, size_t off, int Np, int K, int kind, int lds, int nvalid) { WD w; w.src = src; w.dst = (bf16_t*)(ws + off); w.Np = Np; w.K = K; w.kind = kind; w.lds = lds; w.nvalid = nvalid; return w; }
template <class P> DI void convert_set_a(const P& p, float* tile) {
    for (int s = 0; s < 2; ++s) {
        convert_weight(mkwd(p.in(I_FIN0) + (size_t)s * 1024 * 5632, p.ws, OFF_WIN0 + s * SZ_WIN, 5632, 1024, 1, 5632, 5632), tile);
        convert_weight(mkwd(p.in(I_FOUT0) + (size_t)s * DFF * 1024, p.ws, OFF_WOUT0 + s * SZ_WOUT, 1024, DFF, 0, 1024, 1024), tile); }
    convert_weight(mkwd(p.in(I_RGIN), p.ws, OFF_RGIN, 2048, 1024, 0, 2048, 2048), tile);
    convert_weight(mkwd(p.in(I_RGOUT), p.ws, OFF_RGOUT, 1024, 1024, 0, 1024, 1024), tile);
    convert_weight(mkwd(p.in(I_GATEW), p.ws, OFF_GATE, 4096, 256, 6, 0, 0), tile);
}
template <class P> DI void convert_set_b(const P& p, float* tile) {
    for (int s = 0; s < 2; ++s) {
        convert_weight(mkwd(p.in(I_FIN1) + (size_t)s * 1024 * 5632, p.ws, OFF_WIN1 + s * SZ_WIN, 5632, 1024, 1, 5632, 5632), tile);
        convert_weight(mkwd(p.in(I_FOUT1) + (size_t)s * DFF * 1024, p.ws, OFF_WOUT1 + s * SZ_WOUT, 1024, DFF, 0, 1024, 1024), tile); }
    convert_weight(mkwd(p.in(I_WA), p.ws, OFF_WA, 1024, 1024, 0, 832, 832), tile);
    convert_weight(mkwd(p.in(I_WQB), p.ws, OFF_WQB, 1536, 512, 3, 1536, 1536), tile);
    convert_weight(mkwd(p.in(I_WKVB), p.ws, OFF_WKN, 1024, 256, 4, 2048, 2048), tile);
    convert_weight(mkwd(p.in(I_WKVB), p.ws, OFF_WV, 1024, 256, 5, 2048, 2048), tile);
    convert_weight(mkwd(p.in(I_WO), p.ws, OFF_WO, 1024, 1024, 0, 1024, 1024), tile);
}
DI void prologue_phase(const Params& p, float* lds) {
    const int tid = tid_l(), lane = tid & 63, wv = tid >> 6;
    float* sv = lds;
    float* red = lds + 5 * 1024;
    float* tile = red + 8 * 5 * 64;
    for (int i = tid; i < 5 * 1024; i += 512) { const float v = i < 4096 ? p.in(I_C)[i] : p.in(I_CCTX)[i - 4096]; sv[i] = v * sigm(v); }
    __syncthreads();
    float* MOD = (float*)(p.ws + OFF_MOD);
    for (int it = bid_l(); it < 288; it += gridDim.x) {
        const int layer = it / 144, col = (it % 144) * 64 + lane; const float* W = layer ? p.in(I_MODW1) : p.in(I_MODW0); const float* MB = layer ? p.in(I_MODB1) : p.in(I_MODB0);
        float a0 = 0.f, a1 = 0.f, a2 = 0.f, a3 = 0.f, a4 = 0.f;
#pragma unroll 8
        for (int kk = 0; kk < 128; ++kk) { const int k = wv * 128 + kk; const float w = W[(size_t)k * 9216 + col];
            a0 += sv[k] * w; a1 += sv[1024 + k] * w; a2 += sv[2048 + k] * w; a3 += sv[3072 + k] * w; a4 += sv[4096 + k] * w; }
        red[(wv * 5 + 0) * 64 + lane] = a0; red[(wv * 5 + 1) * 64 + lane] = a1; red[(wv * 5 + 2) * 64 + lane] = a2; red[(wv * 5 + 3) * 64 + lane] = a3; red[(wv * 5 + 4) * 64 + lane] = a4;
        __syncthreads();
        if (tid < 320) { const int v = tid >> 6; float s = 0.f;
#pragma unroll
            for (int w8 = 0; w8 < 8; ++w8) s += red[(w8 * 5 + v) * 64 + lane];
            MOD[(size_t)(layer * 5 + v) * 9216 + col] = s + MB[col]; }
        __syncthreads();
    }
    if (bid_l() == gridDim.x - 1 && tid < 16) {
        double th = 1.0; for (int i = 0; i < tid; ++i) th *= 0.56234132519034908;
        double c1 = 1.0, s1 = th, tc = 1.0, ts = th; const double t2 = th * th;
        for (int n = 1; n <= 12; ++n) { tc *= -t2 / (double)((2 * n - 1) * (2 * n)); ts *= -t2 / (double)((2 * n) * (2 * n + 1)); c1 += tc; s1 += ts; }
        double cc = 1.0, ss = 0.0; float* RT = (float*)(p.ws + OFF_ROPE);
        for (int pos = 0; pos < 64; ++pos) { RT[(pos * 16 + tid) * 2] = (float)cc; RT[(pos * 16 + tid) * 2 + 1] = (float)ss; const double nc = cc * c1 - ss * s1, ns = cc * s1 + ss * c1; cc = nc; ss = ns; }
    }
    if (tid < 27) ((const float**)(p.ws + OFF_TAB))[tid] = p.in(tid);
    convert_set_a(p, tile);
}

struct RowD { int first, pl, psub, pg, pw2, has_next, nl, nsub, ng, M; };
DI void row_phase(const Ctx& p, const RowD d) {
    const int tid = tid_l(), lane = tid & 63, wv = tid >> 6;
    const float* MOD = (const float*)(p.ws + OFF_MOD); float* XC = (float*)(p.ws + OFF_XC);
    bf16_t* Y = (bf16_t*)(p.ws + OFF_Y);
    const float pw = 0.5f * (float)d.pw2;
    for (int r = bid_l() * 8 + wv; r < d.M; r += gridDim.x * 8) {
        const int mb = r < ML ? (r >> 12) : 4;
        float* xs = r < ML ? p.out + (size_t)r * DM : XC + (size_t)(r - ML) * DM;
        const float* xin = d.first ? (r < ML ? p.in(I_X) + (size_t)r * DM : p.in(I_CTX) + (size_t)(r - ML) * DM) : xs;
        f32x4 xv[4];
#pragma unroll
        for (int j = 0; j < 4; ++j) xv[j] = *(const f32x4*)(xin + 256 * j + 4 * lane);
        if (!d.first) {
            u32x2 yv[4]; float ss = 0.f;
#pragma unroll
            for (int j = 0; j < 4; ++j) { yv[j] = *(const u32x2*)(Y + (size_t)r * DM + 256 * j + 4 * lane);
                const float y0 = bflo(yv[j][0]), y1 = bfhi(yv[j][0]), y2 = bflo(yv[j][1]), y3 = bfhi(yv[j][1]); ss += y0 * y0 + y1 * y1 + y2 * y2 + y3 * y3; }
            ss = wave_sum(ss); const float rstd = rsqrtf(ss * (1.f / 1024.f) + 1e-6f) * pw;
            const float* gp = (d.pl ? p.in(I_NORMG1) : p.in(I_NORMG0)) + d.pg * DM; const float* gt = MOD + (size_t)(d.pl * 5 + mb) * 9216 + d.psub * 3072 + 2048;
#pragma unroll
            for (int j = 0; j < 4; ++j) { const f32x4 g4 = *(const f32x4*)(gp + 256 * j + 4 * lane), t4 = *(const f32x4*)(gt + 256 * j + 4 * lane);
                xv[j][0] += t4[0] * g4[0] * rstd * bflo(yv[j][0]); xv[j][1] += t4[1] * g4[1] * rstd * bfhi(yv[j][0]);
                xv[j][2] += t4[2] * g4[2] * rstd * bflo(yv[j][1]); xv[j][3] += t4[3] * g4[3] * rstd * bfhi(yv[j][1]); }
        }
#pragma unroll
        for (int j = 0; j < 4; ++j) *(f32x4*)(xs + 256 * j + 4 * lane) = xv[j];
        if (d.has_next) {
            float ss = 0.f;
#pragma unroll
            for (int j = 0; j < 4; ++j) ss += xv[j][0] * xv[j][0] + xv[j][1] * xv[j][1] + xv[j][2] * xv[j][2] + xv[j][3] * xv[j][3];
            ss = wave_sum(ss); const float rstd = rsqrtf(ss * (1.f / 1024.f) + 1e-6f);
            const float* gp = (d.nl ? p.in(I_NORMG1) : p.in(I_NORMG0)) + d.ng * DM; const float* sh = MOD + (size_t)(d.nl * 5 + mb) * 9216 + d.nsub * 3072; const float* sc = sh + 1024;
            bf16_t* xn = (bf16_t*)(p.ws + OFF_XN) + (size_t)r * DM;
#pragma unroll
            for (int j = 0; j < 4; ++j) { const f32x4 g4 = *(const f32x4*)(gp + 256 * j + 4 * lane), s4 = *(const f32x4*)(sh + 256 * j + 4 * lane), c4 = *(const f32x4*)(sc + 256 * j + 4 * lane);
                float o[4];
#pragma unroll
                for (int i = 0; i < 4; ++i) o[i] = xv[j][i] * rstd * g4[i] * (1.f + c4[i]) + s4[i];
                *(u32x2*)(xn + 256 * j + 4 * lane) = (u32x2){pk2(o[0], o[1]), pk2(o[2], o[3])}; }
        }
    }
}

DI void conv_phase(const Ctx& p) {
    const bf16_t* U = (const bf16_t*)(p.ws + OFF_U); bf16_t* UC = (bf16_t*)(p.ws + OFF_UC); const float* cb_ = p.in(I_CONVB); const float* cw_ = p.in(I_CONVW);
    for (int idx = bid_l() * 512 + tid_l(); idx < MT * 128; idx += gridDim.x * 512) {
        const int r = idx >> 7, c8 = (idx & 127) * 8;
        int t, Ls; if (r < ML) { t = r & 4095; Ls = 4096; } else { t = (r - ML) & 255; Ls = 256; }
        float a[8];
        { const f32x4 b0 = *(const f32x4*)(cb_ + c8), b1 = *(const f32x4*)(cb_ + c8 + 4); a[0] = b0[0]; a[1] = b0[1]; a[2] = b0[2]; a[3] = b0[3]; a[4] = b1[0]; a[5] = b1[1]; a[6] = b1[2]; a[7] = b1[3]; }
#pragma unroll
        for (int k = 0; k < 4; ++k) { const int tt = t + k - 2;
            if (tt >= 0 && tt < Ls) { const u32x4 uu = *(const u32x4*)(U + (size_t)(r + k - 2) * DM + c8);
                const f32x4 w0 = *(const f32x4*)(cw_ + k * DM + c8), w1 = *(const f32x4*)(cw_ + k * DM + c8 + 4);
                a[0] += bflo(uu[0]) * w0[0]; a[1] += bfhi(uu[0]) * w0[1]; a[2] += bflo(uu[1]) * w0[2]; a[3] += bfhi(uu[1]) * w0[3];
                a[4] += bflo(uu[2]) * w1[0]; a[5] += bfhi(uu[2]) * w1[1]; a[6] += bflo(uu[3]) * w1[2]; a[7] += bfhi(uu[3]) * w1[3]; } }
        *(u32x4*)(UC + (size_t)r * DM + c8) = (u32x4){pk2(a[0], a[1]), pk2(a[2], a[3]), pk2(a[4], a[5]), pk2(a[6], a[7])};
    }
}
DI int chunk_row(int b, int k) { return k < 4 ? ML + b * 256 + 64 * k : b * 4096 + 64 * (k - 4); }
DI void scan1_phase(const Ctx& p) {
    const __half2* AB0 = (const __half2*)(p.ws + OFF_AB0); const __half2* AB1 = (const __half2*)(p.ws + OFF_AB1); f32x2* CAR = (f32x2*)(p.ws + OFF_CAR);
    for (int idx = bid_l() * 512 + tid_l(); idx < 4 * NCH * 1024; idx += gridDim.x * 512) {
        const int c = idx & 1023, bk = idx >> 10, b = bk / NCH, k = bk - b * NCH; const size_t base = (size_t)chunk_row(b, k) * DM + c;
        float P0 = 0.f, h0 = 0.f, P1 = 0.f, h1 = 0.f;
#pragma unroll 16
        for (int t = 0; t < 64; ++t) { const float2 v = __half22float2(AB0[base + (size_t)t * DM]); P0 += v.x; h0 = __expf(v.x) * h0 + v.y; }
#pragma unroll 16
        for (int t = 63; t >= 0; --t) { const float2 v = __half22float2(AB1[base + (size_t)t * DM]); P1 += v.x; h1 = __expf(v.x) * h1 + v.y; }
        CAR[(size_t)((0 * 4 + b) * NCH + k) * 1024 + c] = (f32x2){P0, h0}; CAR[(size_t)((1 * 4 + b) * NCH + k) * 1024 + c] = (f32x2){P1, h1};
    }
}
DI void scan3_phase(const Ctx& p) {
    const __half2* AB0 = (const __half2*)(p.ws + OFF_AB0); const __half2* AB1 = (const __half2*)(p.ws + OFF_AB1); const f32x2* CAR = (const f32x2*)(p.ws + OFF_CAR);
    bf16_t* YG = (bf16_t*)(p.ws + OFF_YG);
    for (int idx = bid_l() * 512 + tid_l(); idx < 4 * NCH * 1024; idx += gridDim.x * 512) {
        const int c = idx & 1023, bk = idx >> 10, b = bk / NCH, k = bk - b * NCH; const size_t base = (size_t)chunk_row(b, k) * DM + c;
        const f32x2* C0 = CAR + (size_t)((0 * 4 + b) * NCH) * 1024 + c; const f32x2* C1 = CAR + (size_t)((1 * 4 + b) * NCH) * 1024 + c;
        float hf = 0.f, hr = 0.f;
        for (int kk = 0; kk < k; ++kk) { const f32x2 cv = C0[(size_t)kk * 1024]; hf = __expf(cv[0]) * hf + cv[1]; }
        if (k < 4) { for (int kk = 3; kk > k; --kk) { const f32x2 cv = C1[(size_t)kk * 1024]; hr = __expf(cv[0]) * hr + cv[1]; } }
        else { for (int kk = 3; kk >= 0; --kk) { const f32x2 cv = C1[(size_t)kk * 1024]; hr = __expf(cv[0]) * hr + cv[1]; }
               for (int kk = NCH - 1; kk > k; --kk) { const f32x2 cv = C1[(size_t)kk * 1024]; hr = __expf(cv[0]) * hr + cv[1]; } }
        float hfv[64];
#pragma unroll
        for (int t = 0; t < 64; ++t) { const float2 v = __half22float2(AB0[base + (size_t)t * DM]); hf = __expf(v.x) * hf + v.y; hfv[t] = hf; }
#pragma unroll
        for (int t = 63; t >= 0; --t) { const float2 v = __half22float2(AB1[base + (size_t)t * DM]); hr = __expf(v.x) * hr + v.y;
            const float yg = bf1(YG[base + (size_t)t * DM]); YG[base + (size_t)t * DM] = (bf16_t)(pk2((hfv[t] + hr) * yg, 0.f) & 0xffffu); }
    }
}

DI void mla_norm_phase(const Ctx& p) {
    const int tid = tid_l(), lane = tid & 63, wv = tid >> 6;
    const bf16_t* CA = (const bf16_t*)(p.ws + OFF_CA); bf16_t* CQ = (bf16_t*)(p.ws + OFF_CQ); bf16_t* CKV = (bf16_t*)(p.ws + OFF_CKV); bf16_t* KR = (bf16_t*)(p.ws + OFF_KR);
    const float* RT = (const float*)(p.ws + OFF_ROPE); const float* kvn_ = p.in(I_KVNORM); const float* qn_ = p.in(I_QNORM);
    for (int r = bid_l() * 8 + wv; r < MT; r += gridDim.x * 8) {
        const bf16_t* row = CA + (size_t)r * DM;
        const u32x2 kv = *(const u32x2*)(row + 512 + 4 * lane);
        { const float k0 = bflo(kv[0]), k1 = bfhi(kv[0]), k2 = bflo(kv[1]), k3 = bfhi(kv[1]);
          const float ss = wave_sum(k0 * k0 + k1 * k1 + k2 * k2 + k3 * k3), rstd = rsqrtf(ss * (1.f / 256.f) + 1e-6f);
          const f32x4 g = *(const f32x4*)(kvn_ + 4 * lane);
          *(u32x2*)(CKV + (size_t)r * 256 + 4 * lane) = (u32x2){pk2(k0 * rstd * g[0], k1 * rstd * g[1]), pk2(k2 * rstd * g[2], k3 * rstd * g[3])}; }
        const int o = rope_orig(lane); const float v = bf1(row[768 + o]), vp = bf1(row[768 + (o ^ 16)]); float kr = v;
        if (r < ML) {
            const u32x4 qv = *(const u32x4*)(row + 8 * lane); float q[8] = {bflo(qv[0]), bfhi(qv[0]), bflo(qv[1]), bfhi(qv[1]), bflo(qv[2]), bfhi(qv[2]), bflo(qv[3]), bfhi(qv[3])};
            float ss = 0.f;
#pragma unroll
            for (int i = 0; i < 8; ++i) ss += q[i] * q[i];
            ss = wave_sum(ss); const float rstd = rsqrtf(ss * (1.f / 512.f) + 1e-6f);
            const f32x4 g0 = *(const f32x4*)(qn_ + 8 * lane), g1 = *(const f32x4*)(qn_ + 8 * lane + 4);
            *(u32x4*)(CQ + (size_t)r * 512 + 8 * lane) = (u32x4){pk2(q[0] * rstd * g0[0], q[1] * rstd * g0[1]), pk2(q[2] * rstd * g0[2], q[3] * rstd * g0[3]), pk2(q[4] * rstd * g1[0], q[5] * rstd * g1[1]), pk2(q[6] * rstd * g1[2], q[7] * rstd * g1[3])};
            const int t = r & 4095, pos = (o < 32) ? (t >> 6) : (t & 63); const float cs = RT[(pos * 16 + (o & 15)) * 2], sn = RT[(pos * 16 + (o & 15)) * 2 + 1];
            kr = (o & 16) ? vp * sn + v * cs : v * cs - vp * sn;
        }
        KR[(size_t)r * 64 + lane] = (bf16_t)(pk2(kr, 0.f) & 0xffffu);
    }
}

constexpr int KNB = 0, KRB = 16384, VTB = 24576, ABUF = 40960;
DI void attn_phase(const Ctx& p, LAS unsigned char* lds) {
    const int tid = tid_l(), lane = tid & 63, wv = __builtin_amdgcn_readfirstlane(tid >> 6), ql = lane & 31, hi = lane >> 5;
    const bf16_t* Q = (const bf16_t*)(p.ws + OFF_Q); const bf16_t* KN = (const bf16_t*)(p.ws + OFF_KN); const bf16_t* KR = (const bf16_t*)(p.ws + OFF_KR); const bf16_t* VT = (const bf16_t*)(p.ws + OFF_VT);
    bf16_t* O = (bf16_t*)(p.ws + OFF_O);
    unsigned okn[2], ovt[2], okr;
#pragma unroll
    for (int e = 0; e < 2; ++e) { const int P = (2 * wv + e) * 64 + lane; { const int row = P >> 4, c = (P & 15) ^ (row & 15); okn[e] = (unsigned)(row * 1024 + c * 8); }
        { const int row = P >> 3, c = (P & 7) ^ ((row >> 1) & 7); ovt[e] = (unsigned)(row * NKEY + c * 8); } }
    { const int P = wv * 64 + lane, row = P >> 3, c = (P & 7) ^ ((row >> 1) & 7); okr = (unsigned)(row * 64 + c * 8); }
    const int zk = hi ^ (ql & 15), zr = hi ^ ((ql >> 1) & 7);
    const int rdkn = KNB + ql * 256, rdkr = KRB + ql * 128, rdvt = VTB + ql * 128;
    for (int item = bid_l(); item < 512; item += gridDim.x) {
        const int xcd = item & 7, slot = (item >> 3) & 31, rr = item >> 8, bh = xcd * 2 + (slot >> 4) + 16 * rr, qb = slot & 15, b = bh >> 3, h = bh & 7;
        const int r0 = b * 4096 + qb * 256 + wv * 32 + ql;
        bf16x8 qf[12];
#pragma unroll
        for (int s = 0; s < 12; ++s) qf[s] = *(const bf16x8*)(Q + (size_t)r0 * 1536 + h * 192 + 16 * s + 8 * hi);
        f32x16 oacc[4];
#pragma unroll
        for (int dt = 0; dt < 4; ++dt)
#pragma unroll
            for (int i = 0; i < 16; ++i) oacc[dt][i] = 0.f;
        float mrow = -INFINITY, lrow = 0.f;
        const bf16_t* vbase = VT + ((size_t)(b * 1024 + h * 128)) * NKEY;
#define ATT_DMA(j, buf) do { const int kb_ = (j) < 4 ? ML + b * 256 + 64 * (j) : b * 4096 + 64 * ((j) - 4); LAS unsigned char* sb_ = lds + (buf) * ABUF; \
            const bf16_t* kn_ = KN + (size_t)kb_ * 1024 + h * 128; const bf16_t* kr_ = KR + (size_t)kb_ * 64; const bf16_t* vt_ = vbase + 64 * (j); \
            __builtin_amdgcn_global_load_lds((const unsigned*)(kn_ + okn[0]), (LAS unsigned*)(sb_ + KNB + (2 * wv) * 1024), 16, 0, 0); \
            __builtin_amdgcn_global_load_lds((const unsigned*)(kn_ + okn[1]), (LAS unsigned*)(sb_ + KNB + (2 * wv + 1) * 1024), 16, 0, 0); \
            __builtin_amdgcn_global_load_lds((const unsigned*)(kr_ + okr), (LAS unsigned*)(sb_ + KRB + wv * 1024), 16, 0, 0); \
            __builtin_amdgcn_global_load_lds((const unsigned*)(vt_ + ovt[0]), (LAS unsigned*)(sb_ + VTB + (2 * wv) * 1024), 16, 0, 0); \
            __builtin_amdgcn_global_load_lds((const unsigned*)(vt_ + ovt[1]), (LAS unsigned*)(sb_ + VTB + (2 * wv + 1) * 1024), 16, 0, 0); } while (0)
        ATT_DMA(0, 0);
        asm volatile("s_waitcnt vmcnt(0)" ::: "memory"); __syncthreads();
        for (int j = 0; j < NCH; ++j) {
            if (j + 1 < NCH) ATT_DMA(j + 1, (j + 1) & 1);
            LAS unsigned char* sb = lds + (j & 1) * ABUF;
            f32x16 s0, s1;
#pragma unroll
            for (int i = 0; i < 16; ++i) { s0[i] = 0.f; s1[i] = 0.f; }
#define KOFF(s) ((s) < 8 ? rdkn + (((2 * (s)) ^ zk) << 4) : rdkr + (((2 * ((s) - 8)) ^ zr) << 4))
#define KOFF1(s) ((s) < 8 ? 32 * 256 : 32 * 128)
            { bf16x8 a0 = *(const LAS bf16x8*)(sb + KOFF(0)), a1 = *(const LAS bf16x8*)(sb + KOFF(0) + KOFF1(0));
#pragma unroll
              for (int s = 0; s < 12; ++s) { bf16x8 n0 = a0, n1 = a1;
                  if (s < 11) { n0 = *(const LAS bf16x8*)(sb + KOFF(s + 1)); n1 = *(const LAS bf16x8*)(sb + KOFF(s + 1) + KOFF1(s + 1)); }
                  s0 = __builtin_amdgcn_mfma_f32_32x32x16_bf16(a0, qf[s], s0, 0, 0, 0); s1 = __builtin_amdgcn_mfma_f32_32x32x16_bf16(a1, qf[s], s1, 0, 0, 0);
                  a0 = n0; a1 = n1; __builtin_amdgcn_sched_barrier(0); } }
#undef KOFF
#undef KOFF1
            float mx = s0[0];
#pragma unroll
            for (int i = 1; i < 16; ++i) mx = fmaxf(mx, s0[i]);
#pragma unroll
            for (int i = 0; i < 16; ++i) mx = fmaxf(mx, s1[i]);
            mx = fmaxf(mx, __shfl_xor(mx, 32));
            const float mn = fmaxf(mrow, mx), alpha = __builtin_amdgcn_exp2f(mrow - mn); mrow = mn;
            float ps = 0.f;
#pragma unroll
            for (int i = 0; i < 16; ++i) { s0[i] = __builtin_amdgcn_exp2f(s0[i] - mn); s1[i] = __builtin_amdgcn_exp2f(s1[i] - mn); ps += s0[i] + s1[i]; }
            lrow = lrow * alpha + ps;
#pragma unroll
            for (int dt = 0; dt < 4; ++dt)
#pragma unroll
                for (int i = 0; i < 16; ++i) oacc[dt][i] *= alpha;
            __builtin_amdgcn_sched_barrier(0);
            bf16x8 pf[2][2];
#pragma unroll
            for (int s2 = 0; s2 < 2; ++s2) {
                pf[0][s2] = __builtin_bit_cast(bf16x8, (u32x4){pk2(s0[8 * s2], s0[8 * s2 + 1]), pk2(s0[8 * s2 + 2], s0[8 * s2 + 3]), pk2(s0[8 * s2 + 4], s0[8 * s2 + 5]), pk2(s0[8 * s2 + 6], s0[8 * s2 + 7])});
                pf[1][s2] = __builtin_bit_cast(bf16x8, (u32x4){pk2(s1[8 * s2], s1[8 * s2 + 1]), pk2(s1[8 * s2 + 2], s1[8 * s2 + 3]), pk2(s1[8 * s2 + 4], s1[8 * s2 + 5]), pk2(s1[8 * s2 + 6], s1[8 * s2 + 7])}); }
            __builtin_amdgcn_sched_barrier(0);
#define VOFF(i) (rdvt + ((i) >> 2) * 32 * 128 + (((2 * ((i) & 3)) ^ zr) << 4))
            { bf16x8 a = *(const LAS bf16x8*)(sb + VOFF(0));
#pragma unroll
              for (int i = 0; i < 16; ++i) { bf16x8 n = a; if (i < 15) n = *(const LAS bf16x8*)(sb + VOFF(i + 1));
                  oacc[i >> 2] = __builtin_amdgcn_mfma_f32_32x32x16_bf16(a, pf[(i >> 1) & 1][i & 1], oacc[i >> 2], 0, 0, 0); a = n; __builtin_amdgcn_sched_barrier(0); } }
#undef VOFF
            asm volatile("s_waitcnt vmcnt(0)" ::: "memory");
            __syncthreads();
        }
#undef ATT_DMA
        const float inv = 1.f / (lrow + __shfl_xor(lrow, 32));
#pragma unroll
        for (int dt = 0; dt < 4; ++dt)
#pragma unroll
            for (int rg = 0; rg < 4; ++rg)
                *(u32x2*)(O + (size_t)r0 * DM + h * 128 + 32 * dt + 8 * rg + 4 * hi) = (u32x2){pk2(oacc[dt][4 * rg] * inv, oacc[dt][4 * rg + 1] * inv), pk2(oacc[dt][4 * rg + 2] * inv, oacc[dt][4 * rg + 3] * inv)};
    }
}
struct PD { int kind, sync, M, N, K, lda, ldb, ldo, agrp, rot; unsigned offA, offB, offO; int r[9]; };
enum { K_PRO = 0, K_ROW, K_GSWI, K_GSTORE, K_GRGIN, K_CONV, K_GGATE, K_S1, K_S3, K_MLAN, K_GQ, K_GVT, K_ATT };
#define BIGG (1 << 20)
#define ROWP(first, pl, psub, pg, pw2, hn, nl, nsub, ng, M, convb) {K_ROW, 1, M, 0, 0, 0, 0, 0, convb, 0, 0u, 0u, 0u, {first, pl, psub, pg, pw2, hn, nl, nsub, ng}}
#define GEMMP(kind, sync, M, N, K, lda, ldb, ldo, agrp, rot, offA, offB, offO) {kind, sync, M, N, K, lda, ldb, ldo, agrp, rot, (unsigned)(offA), (unsigned)(offB), (unsigned)(offO), {0, 0, 0, 0, 0, 0, 0, 0, 0}}
#define MISCP(kind) {kind, 1, 0, 0, 0, 0, 0, 0, 0, 0, 0u, 0u, 0u, {0, 0, 0, 0, 0, 0, 0, 0, 0}}
#define G1P(offW, M) GEMMP(K_GSWI, 1, M, 5632, 1024, 1024, 1024, 2816, BIGG, 0, OFF_XN, offW, OFF_H)
#define G2P(offW, M) GEMMP(K_GSTORE, 1, M, 1024, 2816, 2816, 2816, 1024, BIGG, 0, OFF_H, offW, OFF_Y)
constexpr int NPH = 29;
__device__ const PD PROG[NPH] = {
    MISCP(K_PRO),
    ROWP(1, 0, 0, 0, 0, 1, 0, 0, 0, MT, 0),
    G1P(OFF_WIN0, MT), G2P(OFF_WOUT0, MT),
    ROWP(0, 0, 0, 1, 1, 1, 0, 1, 2, MT, 0),
    GEMMP(K_GRGIN, 1, MT, 2048, 1024, 1024, 1024, 1024, BIGG, 0, OFF_XN, OFF_RGIN, 0),
    MISCP(K_CONV),
    GEMMP(K_GGATE, 1, MT, 4096, 256, 1024, 256, 0, 4, 0, OFF_UC, OFF_GATE, 0),
    MISCP(K_S1), MISCP(K_S3),
    GEMMP(K_GSTORE, 1, MT, 1024, 1024, 1024, 1024, 1024, BIGG, 0, OFF_YG, OFF_RGOUT, OFF_Y),
    ROWP(0, 0, 1, 3, 2, 1, 0, 2, 4, MT, 1),
    G1P(OFF_WIN0 + SZ_WIN, MT), G2P(OFF_WOUT0 + SZ_WOUT, MT),
    ROWP(0, 0, 2, 5, 1, 1, 1, 0, 0, MT, 0),
    G1P(OFF_WIN1, MT), G2P(OFF_WOUT1, MT),
    ROWP(0, 1, 0, 1, 1, 1, 1, 1, 2, MT, 0),
    GEMMP(K_GSTORE, 1, MT, 1024, 1024, 1024, 1024, 1024, BIGG, 0, OFF_XN, OFF_WA, OFF_CA),
    MISCP(K_MLAN),
    GEMMP(K_GQ, 0, ML, 1536, 512, 512, 512, 1536, BIGG, 0, OFF_CQ, OFF_WQB, OFF_Q),
    GEMMP(K_GSTORE, 0, MT, 1024, 256, 256, 256, 1024, BIGG, 128, OFF_CKV, OFF_WKN, OFF_KN),
    GEMMP(K_GVT, 1, 1024, MT, 256, 256, 256, 0, BIGG, 64, OFF_WV, OFF_CKV, OFF_VT),
    MISCP(K_ATT),
    GEMMP(K_GSTORE, 1, ML, 1024, 1024, 1024, 1024, 1024, BIGG, 0, OFF_O, OFF_WO, OFF_Y),
    ROWP(0, 1, 1, 3, 2, 1, 1, 2, 4, ML, 0),
    G1P(OFF_WIN1 + SZ_WIN, ML), G2P(OFF_WOUT1 + SZ_WOUT, ML),
    ROWP(0, 1, 2, 5, 1, 0, 0, 0, 0, ML, 0),
};

template <class Epi> DI void run_gemm(LAS unsigned char* lds, const Ctx& p, const PD& d, const Epi& E) {
    pg8::Gemm g; g.A = (const bf16_t*)(p.ws + d.offA); g.Bt = (const bf16_t*)(p.ws + d.offB); g.M = d.M; g.N = d.N; g.K = d.K; g.lda = d.lda; g.ldb = d.ldb; g.agrp = d.agrp;
    pg8::StaticOrder S; S.init(d.M, d.N, (int)gridDim.x, (int)((bid_l() + (unsigned)d.rot) % gridDim.x));
    pg8::gemm_phase<Epi, pg8::StaticOrder, false>(lds, g, S, E, nullptr);
}

__global__ void __launch_bounds__(512, 2) mega_fwd(Params kp) {
    extern __shared__ __attribute__((aligned(16))) unsigned char shm[];
    cg::grid_group grid = cg::this_grid();
    LAS unsigned char* lds = (LAS unsigned char*)shm;
    int ph = kp.ph_lo;
    if (ph == 0) { prologue_phase(kp, (float*)shm); ph = 1; if (ph < kp.ph_hi) grid.sync(); }
    for (; ph < kp.ph_hi; ++ph) {
        Ctx p; { unsigned char* w = kp.ws; float* o = kp.out; asm volatile("" : "+s"(w), "+s"(o)); p.ws = w; p.out = o; p.tab = (const float* const*)(w + OFF_TAB); }
        const PD& d = PROG[ph];
        switch (d.kind) {
            case K_ROW: { if (d.agrp) { convert_set_b(p, (float*)shm); }
                RowD rd; rd.first = d.r[0]; rd.pl = d.r[1]; rd.psub = d.r[2]; rd.pg = d.r[3]; rd.pw2 = d.r[4]; rd.has_next = d.r[5]; rd.nl = d.r[6]; rd.nsub = d.r[7]; rd.ng = d.r[8]; rd.M = d.M; row_phase(p, rd); } break;
            case K_GSWI: { EpiSwiglu E; E.H = (bf16_t*)(p.ws + d.offO); run_gemm(lds, p, d, E); } break;
            case K_GSTORE: { EpiStore E; E.O = (bf16_t*)(p.ws + d.offO); E.ldo = d.ldo; run_gemm(lds, p, d, E); } break;
            case K_GRGIN: { EpiRgIn E; E.YG = (bf16_t*)(p.ws + OFF_YG); E.U = (bf16_t*)(p.ws + OFF_U); run_gemm(lds, p, d, E); } break;
            case K_CONV: conv_phase(p); break;
            case K_GGATE: { EpiGate E; E.UC = (const bf16_t*)(p.ws + OFF_UC); E.gate_b = p.in(I_GATEB); E.lam = p.in(I_LAM); E.AB0 = (__half2*)(p.ws + OFF_AB0); E.AB1 = (__half2*)(p.ws + OFF_AB1); run_gemm(lds, p, d, E); } break;
            case K_S1: scan1_phase(p); break;
            case K_S3: scan3_phase(p); break;
            case K_MLAN: mla_norm_phase(p); break;
            case K_GQ: { EpiQ E; E.Q = (bf16_t*)(p.ws + OFF_Q); E.rope = (const float*)(p.ws + OFF_ROPE); run_gemm(lds, p, d, E); } break;
            case K_GVT: { EpiVT E; E.VT = (bf16_t*)(p.ws + OFF_VT); run_gemm(lds, p, d, E); } break;
            case K_ATT: attn_phase(p, lds); break;
            default: break;
        }
        if (d.sync && ph + 1 < kp.ph_hi) grid.sync();
    }
}

extern "C" void kernel_launch(void* const* d_in, const int* in_sizes, int n_in, void* d_out, int out_size, void* d_ws, size_t ws_size, hipStream_t stream) {
    static int grid_blocks = 0;
    if (!grid_blocks) {
        int dev = 0, cus = 0, per_cu = 0;
        (void)hipGetDevice(&dev);
        (void)hipDeviceGetAttribute(&cus, hipDeviceAttributeMultiprocessorCount, dev);
        if (hipFuncSetAttribute((const void*)mega_fwd, hipFuncAttributeMaxDynamicSharedMemorySize, LDS_BYTES) != hipSuccess) { fprintf(stderr, "kernel_launch: hipFuncSetAttribute failed\n"); }
        (void)hipOccupancyMaxActiveBlocksPerMultiprocessor(&per_cu, (const void*)mega_fwd, 512, LDS_BYTES);
        if (per_cu < 1) { fprintf(stderr, "kernel_launch: occupancy query reports %d blocks per CU\n", per_cu); per_cu = 1; }
        grid_blocks = cus;
        (void)hipGetLastError();
    }
    if (n_in != 27 || ws_size < WS_TOTAL) { fprintf(stderr, "kernel_launch: unexpected n_in %d or workspace %zu < %zu\n", n_in, ws_size, (size_t)WS_TOTAL); return; }
    Params p{};
    for (int i = 0; i < 27; ++i) p.inp[i] = (const float*)d_in[i];
    p.out = (float*)d_out; p.ws = (unsigned char*)d_ws; p.ph_lo = 0; p.ph_hi = NPH;
    void* args[] = {&p};
    hipError_t e = hipLaunchCooperativeKernel((const void*)mega_fwd, dim3(grid_blocks), dim3(512), args, LDS_BYTES, stream);
    if (e != hipSuccess) fprintf(stderr, "kernel_launch: cooperative launch failed: %s (grid %d)\n", hipGetErrorString(e), grid_blocks);
}
```

```cpp
#include <hip/hip_runtime.h>
#include <hip/hip_cooperative_groups.h>
#include <hip/hip_fp16.h>
#include <cstdio>
namespace cg = cooperative_groups;
__device__ __forceinline__ int tid_l() { int t = threadIdx.x; asm volatile("" : "+v"(t)); return t; }
__device__ __forceinline__ int bid_l() { int b = blockIdx.x; asm volatile("" : "+s"(b)); return b; }
#define XB_TMO      128
#define XB_XCNT(j)  (256  + 64 * (j))
#define XB_XSUB(j)  (1280 + 64 * (j))
#define XB_XGEN(j)  (2304 + 64 * (j))
#define XB_TOP      3328
#define XB_TOPGEN   3392
#define XCD_BAR_WORDS 3456
#define XB_SPIN_CAP (1u << 18)
#define XLAS __attribute__((address_space(3)))

__device__ __forceinline__ unsigned xb_ld(unsigned* p)              { return __hip_atomic_load(p, __ATOMIC_RELAXED, __HIP_MEMORY_SCOPE_AGENT); }
__device__ __forceinline__ unsigned xb_add(unsigned* p, unsigned v) { return __hip_atomic_fetch_add(p, v, __ATOMIC_RELAXED, __HIP_MEMORY_SCOPE_AGENT); }
__device__ __forceinline__ unsigned xb_xcc_id() { return (unsigned)__builtin_amdgcn_s_getreg((3 << 11) | 20) & 0xFu; }
#define XB_SPIN(cond, bar) do { unsigned _sp = 0; while (cond) { __builtin_amdgcn_s_sleep(1); \
    if ((++_sp & 255u) == 0u) { if (xb_ld(&(bar)[XB_TMO])) break; if (_sp > XB_SPIN_CAP) { atomicAdd(&(bar)[XB_TMO], 1u); break; } } } } while (0)

struct XcdBarrier {
    unsigned* bar; unsigned x;
    volatile XLAS unsigned* st;
};

__device__ __forceinline__ XcdBarrier xcd_barrier_post(unsigned* bar, volatile XLAS unsigned* st) {
    XcdBarrier b; b.bar = bar; b.x = xb_xcc_id(); b.st = st;
    if (tid_l() == 0) (void)xb_add(&bar[XB_XCNT(b.x)], 1u);
    return b;
}
__device__ __forceinline__ void xcd_barrier_complete(unsigned* bar, unsigned x, unsigned& nloc, unsigned& nx) {
    const unsigned G = gridDim.x * gridDim.y * gridDim.z;
    unsigned sum, cnt, mine, sp = 0u;
    for (;;) {
        sum = 0u; cnt = 0u; mine = 0u;
#pragma unroll
        for (unsigned j = 0; j < 16; ++j) { const unsigned c = xb_ld(&bar[XB_XCNT(j)]); sum += c; cnt += (c > 0u) ? 1u : 0u; mine = (j == x) ? c : mine; }
        if (sum == G) break;
        __builtin_amdgcn_s_sleep(1);
        if ((++sp & 255u) == 0u) { if (xb_ld(&bar[XB_TMO])) break; if (sp > XB_SPIN_CAP) { atomicAdd(&bar[XB_TMO], 1u); break; } }
    }
    nloc = mine > 0u ? mine : 1u; nx = cnt > 0u ? cnt : 1u;
}

__device__ __forceinline__ void xcd_barrier(const XcdBarrier& b) {
    asm volatile("s_waitcnt vmcnt(0)" ::: "memory");
    __syncthreads();
    if (tid_l() == 0) {
        unsigned* bar = b.bar;
        __builtin_amdgcn_s_waitcnt(0);
        unsigned nloc = b.st[0], nx = b.st[1];
        if (nloc == 0u) { xcd_barrier_complete(bar, b.x, nloc, nx); b.st[0] = nloc; b.st[1] = nx; }
        const unsigned old = xb_add(&bar[XB_XSUB(b.x)], 1u);
        const unsigned gen = old / nloc;
        if (old + 1u == (gen + 1u) * nloc) {
            __builtin_amdgcn_fence(__ATOMIC_RELEASE, "agent");
            asm volatile("s_waitcnt vmcnt(0)" ::: "memory");
            const unsigned og = xb_add(&bar[XB_TOP], 1u);
            const unsigned tg = og / nx;
            if (og + 1u == (tg + 1u) * nx) xb_add(&bar[XB_TOPGEN], 1u);
            else XB_SPIN(xb_ld(&bar[XB_TOPGEN]) == tg, bar);
            __builtin_amdgcn_fence(__ATOMIC_ACQUIRE, "agent");
            xb_add(&bar[XB_XGEN(b.x)], 1u);
            asm volatile("s_waitcnt vmcnt(0)" ::: "memory");
        } else {
            XB_SPIN(xb_ld(&bar[XB_XGEN(b.x)]) == gen, bar);
            __builtin_amdgcn_fence(__ATOMIC_ACQUIRE, "agent");
            asm volatile("s_waitcnt vmcnt(0)" ::: "memory");
        }
    }
    __syncthreads();
}

namespace pg8 {
#define PG8_LAS __attribute__((address_space(3)))
typedef unsigned short bf16_t;
typedef short bf16x8 __attribute__((ext_vector_type(8)));
typedef float f32x4 __attribute__((ext_vector_type(4)));
typedef unsigned u32x4 __attribute__((ext_vector_type(4)));
constexpr int BM = 256, BK = 64, HALF = 128, HTB = HALF * BK * 2  , STAGE_BYTES = 8 * HTB, NXCD = 8, WGM = 4;

__host__ __device__ __forceinline__ int lds_byte(int r, int c) { const int st = (r >> 4) * 2 + (c >> 5), rr = r & 15, cc = c & 31, ob = rr * 64 + cc * 2; return st * 1024 + (ob ^ (((ob >> 9) & 1) << 5)); }
__host__ __device__ __forceinline__ void stage_rc(int b, int& R, int& C) { const int st = b / 1024, sb = b % 1024, swz = sb ^ (((sb >> 9) & 1) << 5); R = (st >> 1) * 16 + swz / 64; C = (st & 1) * 32 + (swz % 64) / 2; }
__host__ __device__ __forceinline__ int perm32(int rho) { const int n = rho >> 4, i = rho & 15; return 8 * (i >> 2) + 4 * n + (i & 3); }

struct Unit { int pm, pn; };
struct Gemm { const bf16_t* A; const bf16_t* Bt; int M, N, K, lda, ldb, agrp, bmod; };

struct StaticOrder {
    int nM, nN, nwg, G, c;
    __host__ __device__ void init(int M, int N, int G_, int c_) { nM = M / BM; nN = N / BM; nwg = nM * nN; G = G_; c = c_; }
    __host__ __device__ bool next(int i, Unit& u) const {
        const long L = (long)i * G + c; if (L >= nwg) return false;
        int wgid = (int)L; { const int q = nwg / NXCD, r = nwg % NXCD, xcd = wgid % NXCD, off = wgid / NXCD; wgid = (xcd < r ? xcd * (q + 1) : r * (q + 1) + (xcd - r) * q) + off; }
        const int nig = WGM * nN, gid = wgid / nig, fm = gid * WGM, gsz = (nM - fm) < WGM ? (nM - fm) : WGM;
        u.pm = fm + ((wgid % nig) % gsz); u.pn = (wgid % nig) / gsz; return true;
    }
    __device__ __forceinline__ void a_ready(const Unit&) const {}
    __device__ __forceinline__ void done(const Unit&) const {}
};
template <class Epi, class Sched, bool STAMP = false>
__device__ __forceinline__ void gemm_phase(PG8_LAS unsigned char* lds, const Gemm g, const Sched& S, const Epi& E, unsigned long long* stamps) {
    const int tid = tid_l(), wid = __builtin_amdgcn_readfirstlane(tid >> 6), lane = tid & 63, wr = wid >> 2, wc = wid & 3, fr = lane & 15, fq = lane >> 4;
    const int K = g.K, nt = K / BK;
    unsigned voffA[2], voffB[2];
#pragma unroll
    for (int i = 0; i < 2; ++i) { int R, C; stage_rc(tid * 16 + i * 8192, R, C); const int Rb = Epi::PERM ? ((R & ~31) + perm32(R & 31)) : R;
        voffA[i] = (unsigned)(R * g.lda + C) * 2u; voffB[i] = (unsigned)(Rb * g.ldb + C) * 2u; }
    const size_t kstep = (size_t)(BK * 2);
    const size_t hstepA = (size_t)HALF * g.lda * 2, hstepB = (size_t)HALF * g.ldb * 2;
    const size_t tstepA = 2 * hstepA, tstepB = 2 * hstepB;
    const unsigned ldsw = (unsigned)wid * 1024u;
    const int aoff = lds_byte(wr * 64 + fr, fq * 8), boff = lds_byte(wc * 32 + fr, fq * 8);
#define PG8_SA(b, h) (((b) * 2 + (h)) * HTB)
#define PG8_SB(b, h) ((4 + (b) * 2 + (h)) * HTB)
#define PG8_STAGE(bufoff, gbase, voff) do { _Pragma("unroll") for (int _i = 0; _i < 2; ++_i) \
        __builtin_amdgcn_global_load_lds((const unsigned*)((const char*)(gbase) + (voff)[_i]), (PG8_LAS unsigned*)(lds + (bufoff) + ldsw + _i * 8192), 16, 0, 0); } while (0)
#define PG8_LDA(dst, b, h) do { _Pragma("unroll") for (int m = 0; m < 4; ++m) _Pragma("unroll") for (int k = 0; k < 2; ++k) dst[m][k] = *(const PG8_LAS bf16x8*)(lds + PG8_SA(b, h) + aoff + m * 2048 + k * 1024); } while (0)
#define PG8_LDB(dst, b, h) do { _Pragma("unroll") for (int n = 0; n < 2; ++n) _Pragma("unroll") for (int k = 0; k < 2; ++k) dst[n][k] = *(const PG8_LAS bf16x8*)(lds + PG8_SB(b, h) + boff + n * 2048 + k * 1024); } while (0)
#define PG8_MMA(ai, bj, At, Bt) do { __builtin_amdgcn_s_setprio(1); _Pragma("unroll") for (int m = 0; m < 4; ++m) _Pragma("unroll") for (int n = 0; n < 2; ++n) _Pragma("unroll") for (int k = 0; k < 2; ++k) \
        acc[ai][bj][m][n] = __builtin_amdgcn_mfma_f32_16x16x32_bf16(Bt[n][k], At[m][k], acc[ai][bj][m][n], 0, 0, 0); __builtin_amdgcn_s_setprio(0); } while (0)
#define PG8_WAIT_V(n) asm volatile("s_waitcnt vmcnt(" #n ")" ::: "memory")
#define PG8_WAIT_L(n) asm volatile("s_waitcnt lgkmcnt(" #n ")" ::: "memory")
#define PG8_BAR __builtin_amdgcn_s_barrier()
#define PG8_SCHED __builtin_amdgcn_sched_barrier(0)
    Unit cur, nxt; int ui = 0;
    if (!S.next(0, cur)) return;
    f32x4 acc[2][2][4][2];
#pragma unroll
    for (int a = 0; a < 2; ++a)
#pragma unroll
        for (int b = 0; b < 2; ++b)
#pragma unroll
            for (int m = 0; m < 4; ++m)
#pragma unroll
                for (int n = 0; n < 2; ++n) acc[a][b][m][n] = (f32x4){0.f, 0.f, 0.f, 0.f};
    bf16x8 At[4][2], B0[2][2], B1[2][2];
    const char* cA = (const char*)g.A + (size_t)cur.pm * tstepA + (size_t)(cur.pn / g.agrp) * K * 2; const char* cB = (const char*)g.Bt + (size_t)(cur.pn % g.bmod) * tstepB + (size_t)(cur.pn / g.bmod) * K * 2;
    S.a_ready(cur);
    PG8_STAGE(PG8_SB(0, 0), cB, voffB); PG8_STAGE(PG8_SA(0, 0), cA, voffA); PG8_STAGE(PG8_SB(0, 1), cB + hstepB, voffB); PG8_STAGE(PG8_SA(0, 1), cA + hstepA, voffA);
    if (wr == 1) PG8_BAR;
    PG8_WAIT_V(4); PG8_BAR;
    PG8_STAGE(PG8_SB(1, 0), cB + kstep, voffB); PG8_STAGE(PG8_SA(1, 0), cA + kstep, voffA); PG8_STAGE(PG8_SB(1, 1), cB + hstepB + kstep, voffB);
    PG8_WAIT_V(6); PG8_BAR;
    for (;;) {
        const bool has_next = S.next(ui + 1, nxt);
        const char* nA = has_next ? (const char*)g.A + (size_t)nxt.pm * tstepA + (size_t)(nxt.pn / g.agrp) * K * 2 : cA; const char* nB = has_next ? (const char*)g.Bt + (size_t)(nxt.pn % g.bmod) * tstepB + (size_t)(nxt.pn / g.bmod) * K * 2 : cB;
        for (int t = 0; t < nt; t += 2) {
            const bool last = (t == nt - 2);
            const char* a1 = cA + (size_t)(t + 1) * kstep;
            const char* a2 = last ? nA : cA + (size_t)(t + 2) * kstep; const char* b2 = last ? nB : cB + (size_t)(t + 2) * kstep;
            const char* a3 = a2 + kstep; const char* b3 = b2 + kstep;
            if (last && has_next) S.a_ready(nxt);
            PG8_LDB(B0, 0, 0); PG8_SCHED; PG8_LDA(At, 0, 0); PG8_STAGE(PG8_SA(1, 1), a1 + hstepA, voffA);
            PG8_WAIT_L(8); PG8_BAR; PG8_WAIT_L(0); PG8_MMA(0, 0, At, B0); PG8_BAR; PG8_SCHED;
            PG8_LDB(B1, 0, 1); PG8_STAGE(PG8_SB(0, 0), b2, voffB);
            PG8_BAR; PG8_WAIT_L(0); PG8_MMA(0, 1, At, B1); PG8_BAR;
            PG8_LDA(At, 0, 1); PG8_STAGE(PG8_SA(0, 0), a2, voffA);
            PG8_BAR; PG8_WAIT_L(0); PG8_MMA(1, 0, At, B0); PG8_BAR; PG8_SCHED;
            PG8_STAGE(PG8_SB(0, 1), b2 + hstepB, voffB);
            PG8_WAIT_V(6); PG8_BAR; PG8_MMA(1, 1, At, B1); PG8_BAR;
            PG8_LDB(B0, 1, 0); PG8_SCHED; PG8_LDA(At, 1, 0); PG8_STAGE(PG8_SA(0, 1), a2 + hstepA, voffA);
            PG8_WAIT_L(8); PG8_BAR; PG8_WAIT_L(0); PG8_MMA(0, 0, At, B0); PG8_BAR; PG8_SCHED;
            PG8_LDB(B1, 1, 1); PG8_STAGE(PG8_SB(1, 0), b3, voffB);
            PG8_BAR; PG8_WAIT_L(0); PG8_MMA(0, 1, At, B1); PG8_BAR;
            PG8_LDA(At, 1, 1); PG8_STAGE(PG8_SA(1, 0), a3, voffA);
            PG8_BAR; PG8_WAIT_L(0); PG8_MMA(1, 0, At, B0); PG8_BAR; PG8_SCHED;
            PG8_STAGE(PG8_SB(1, 1), b3 + hstepB, voffB);
            PG8_WAIT_V(6); PG8_BAR; PG8_MMA(1, 1, At, B1); PG8_BAR;
        }
        if constexpr (!Epi::AFTER_DRAIN) { E(acc, cur, wr, wc, fr, fq); S.done(cur); }
        if (!has_next) break;
#pragma unroll
        for (int a = 0; a < 2; ++a)
#pragma unroll
            for (int b = 0; b < 2; ++b)
#pragma unroll
                for (int m = 0; m < 4; ++m)
#pragma unroll
                    for (int n = 0; n < 2; ++n) acc[a][b][m][n] = (f32x4){0.f, 0.f, 0.f, 0.f};
        cur = nxt; cA = nA; cB = nB; ++ui;
    }
    PG8_WAIT_V(0);
    if (wr == 0) PG8_BAR;
    PG8_BAR;
    if constexpr (Epi::AFTER_DRAIN) { E.fused(acc, cur, wr, wc, fr, fq, lds, wid, lane); S.done(cur); }
#undef PG8_SA
#undef PG8_SB
#undef PG8_STAGE
#undef PG8_LDA
#undef PG8_LDB
#undef PG8_MMA
#undef PG8_WAIT_V
#undef PG8_WAIT_L
#undef PG8_BAR
#undef PG8_SCHED
}
}
#define DI __device__ __forceinline__
#define LAS __attribute__((address_space(3)))
#define GAS __attribute__((address_space(1)))
using pg8::bf16_t; using pg8::bf16x8; using pg8::f32x4; using pg8::u32x4; using pg8::Unit;
typedef float f32x2 __attribute__((ext_vector_type(2)));
typedef float f32x16 __attribute__((ext_vector_type(16)));
typedef unsigned u32x2 __attribute__((ext_vector_type(2)));
typedef __bf16 bf2_t __attribute__((ext_vector_type(2)));
constexpr int DM = 1024, ML = 16384, MC = 1024, MT = ML + MC, DFF = 2816, NKEY = 4352, NCH = 68  ;
constexpr size_t MiB = 1048576;
constexpr size_t OFF_MOD = 0, OFF_ROPE = MiB / 2, OFF_CAR = 256 * MiB  , OFF_XC = 6 * MiB;
constexpr size_t OFF_WIN0 = 10 * MiB, OFF_WOUT0 = 32 * MiB, OFF_RGIN = 43 * MiB, OFF_RGOUT = 47 * MiB, OFF_GATE = 49 * MiB;
constexpr size_t SZ_WIN = (size_t)5632 * 1024 * 2, SZ_WOUT = (size_t)1024 * 2816 * 2;
constexpr size_t OFF_R0 = 52 * MiB, OFF_R1 = 86 * MiB, OFF_R2 = 120 * MiB;
constexpr size_t OFF_XN = OFF_R0, OFF_UC = OFF_R0, OFF_Y = OFF_R0, OFF_VT = OFF_R0;
constexpr size_t OFF_H = OFF_R1, OFF_YG = OFF_R1, OFF_CA = OFF_R1, OFF_O = OFF_R1;
constexpr size_t OFF_U = OFF_R2, OFF_AB0 = 120 * MiB, OFF_AB1 = 188 * MiB;
constexpr size_t OFF_WIN1 = 180 * MiB, OFF_WOUT1 = 202 * MiB, OFF_WA = 213 * MiB, OFF_WQB = 215 * MiB, OFF_WKN = 216 * MiB + MiB / 2, OFF_WV = 217 * MiB, OFF_WO = 217 * MiB + MiB / 2;
constexpr size_t OFF_Q = 120 * MiB, OFF_CKV = 168 * MiB, OFF_KR = 177 * MiB, OFF_KN = 220 * MiB, OFF_CQ = 256 * MiB, WS_TOTAL = 272 * MiB;
constexpr size_t OFF_PART = 220 * MiB;
constexpr int LDS_BYTES = 131072;
constexpr float QSCALE = 0.07216878364870322f * 1.4426950408889634f;

constexpr size_t OFF_BAR = MiB / 2 + 131072;
constexpr size_t OFF_TAB = MiB / 2 + 65536;
struct Params {
    const float* inp[27]; float* out; unsigned char* ws; int ph_lo, ph_hi;
    DI const float* in(int i) const { return inp[i]; }
};
struct Ctx {
    unsigned char* ws; float* out; const float* const* tab;
    DI const float* in(int i) const { return (const float*)(GAS const float*)(unsigned long long)tab[i]; }
};
enum { I_X = 0, I_C, I_CTX, I_CCTX, I_MODW0, I_MODB0, I_NORMG0, I_FIN0, I_FOUT0, I_RGIN, I_CONVW, I_CONVB, I_GATEW, I_GATEB, I_LAM, I_RGOUT, I_MODW1, I_MODB1, I_NORMG1, I_FIN1, I_FOUT1, I_WA, I_QNORM, I_KVNORM, I_WQB, I_WKVB, I_WO };
DI unsigned pk2(float a, float b) { f32x2 v = {a, b}; return __builtin_bit_cast(unsigned, __builtin_convertvector(v, bf2_t)); }
DI float bflo(unsigned u) { return __uint_as_float(u << 16); }
DI float bfhi(unsigned u) { return __uint_as_float(u & 0xffff0000u); }
DI float bf1(bf16_t v) { return __uint_as_float(((unsigned)v) << 16); }
template <int CTRL> DI float dpp_f(float v) { return __int_as_float(__builtin_amdgcn_mov_dpp(__float_as_int(v), CTRL, 0xf, 0xf, true)); }
DI float wave_sum(float v) {
    v += dpp_f<0xB1>(v); v += dpp_f<0x4E>(v); v += dpp_f<0x141>(v); v += dpp_f<0x140>(v);
    { const auto r = __builtin_amdgcn_permlane16_swap(__float_as_uint(v), __float_as_uint(v), false, false); v = __uint_as_float(r[0]) + __uint_as_float(r[1]); }
    { const auto r = __builtin_amdgcn_permlane32_swap(__float_as_uint(v), __float_as_uint(v), false, false); v = __uint_as_float(r[0]) + __uint_as_float(r[1]); }
    return v; }
DI float sigm(float x) { return __builtin_amdgcn_rcpf(1.f + __expf(-x)); }
DI int rope_orig(int p) { const int pid = 4 * (p >> 3) + (p & 3), s = (p >> 2) & 1; return (pid >> 4) * 32 + s * 16 + (pid & 15); }

struct EpiStore {
    static constexpr bool PERM = true, AFTER_DRAIN = false;
    bf16_t* O; int ldo;
    DI void operator()(const f32x4 (&acc)[2][2][4][2], const Unit& u, int wr, int wc, int fr, int fq) const {
        const int row0 = u.pm * 256 + wr * 64 + fr, col0 = u.pn * 256 + wc * 32 + 8 * fq;
#pragma unroll
        for (int ai = 0; ai < 2; ++ai)
#pragma unroll
            for (int m = 0; m < 4; ++m) { bf16_t* rowp = O + (size_t)(row0 + ai * 128 + m * 16) * ldo + col0;
#pragma unroll
                for (int bj = 0; bj < 2; ++bj) { const f32x4 v0 = acc[ai][bj][m][0], v1 = acc[ai][bj][m][1];
                    *(u32x4*)(rowp + bj * 128) = (u32x4){pk2(v0[0], v0[1]), pk2(v0[2], v0[3]), pk2(v1[0], v1[1]), pk2(v1[2], v1[3])}; } }
    }
};
struct EpiPart {
    static constexpr bool PERM = false, AFTER_DRAIN = false;
    float* P; int nct;
    DI void operator()(const f32x4 (&acc)[2][2][4][2], const Unit& u, int wr, int wc, int fr, int fq) const {
        const int ld = nct * 256, row0 = u.pm * 256 + wr * 64 + fr, col0 = (u.pn % nct) * 256 + wc * 32 + 4 * fq; float* base = P + (size_t)(u.pn / nct) * 1024 * ld;
#pragma unroll
        for (int ai = 0; ai < 2; ++ai)
#pragma unroll
            for (int m = 0; m < 4; ++m) { float* rowp = base + (size_t)(row0 + ai * 128 + m * 16) * ld + col0;
#pragma unroll
                for (int bj = 0; bj < 2; ++bj)
#pragma unroll
                    for (int n = 0; n < 2; ++n) *(f32x4*)(rowp + bj * 128 + n * 16) = acc[ai][bj][m][n]; }
    }
};
struct EpiSwiglu {
    static constexpr bool PERM = true, AFTER_DRAIN = false;
    bf16_t* H;
    DI void operator()(const f32x4 (&acc)[2][2][4][2], const Unit& u, int wr, int wc, int fr, int fq) const {
        const int row0 = u.pm * 256 + wr * 64 + fr, col0 = u.pn * 128 + wc * 32 + 8 * fq;
#pragma unroll
        for (int ai = 0; ai < 2; ++ai)
#pragma unroll
            for (int m = 0; m < 4; ++m) { float h[8];
#pragma unroll
                for (int n = 0; n < 2; ++n)
#pragma unroll
                    for (int i = 0; i < 4; ++i) { const float a = acc[ai][0][m][n][i], b = acc[ai][1][m][n][i]; h[n * 4 + i] = a * sigm(a) * b; }
                *(u32x4*)(H + (size_t)(row0 + ai * 128 + m * 16) * DFF + col0) = (u32x4){pk2(h[0], h[1]), pk2(h[2], h[3]), pk2(h[4], h[5]), pk2(h[6], h[7])}; }
    }
};
DI float gelu_tanh(float x) { const float z = 0.7978845608028654f * (x + 0.044715f * x * x * x); return x * sigm(2.f * z); }
struct EpiRgIn {
    static constexpr bool PERM = true, AFTER_DRAIN = false;
    bf16_t* YG; bf16_t* U;
    DI void operator()(const f32x4 (&acc)[2][2][4][2], const Unit& u, int wr, int wc, int fr, int fq) const {
        const int row0 = u.pm * 256 + wr * 64 + fr, col0 = (u.pn & 3) * 256 + wc * 32 + 8 * fq; const bool isy = u.pn < 4; bf16_t* dst = isy ? YG : U;
#pragma unroll
        for (int ai = 0; ai < 2; ++ai)
#pragma unroll
            for (int m = 0; m < 4; ++m) { bf16_t* rowp = dst + (size_t)(row0 + ai * 128 + m * 16) * DM + col0;
#pragma unroll
                for (int bj = 0; bj < 2; ++bj) { f32x4 v0 = acc[ai][bj][m][0], v1 = acc[ai][bj][m][1];
                    if (isy) {
#pragma unroll
                        for (int i = 0; i < 4; ++i) { v0[i] = gelu_tanh(v0[i]); v1[i] = gelu_tanh(v1[i]); } }
                    *(u32x4*)(rowp + bj * 128) = (u32x4){pk2(v0[0], v0[1]), pk2(v0[2], v0[3]), pk2(v1[0], v1[1]), pk2(v1[2], v1[3])}; } }
    }
};
DI float neg_expm1(float x) {
    const float pl = -x * (1.f + x * 0.5f * (1.f + x * (1.f / 3.f) * (1.f + x * 0.25f * (1.f + x * 0.2f * (1.f + x * (1.f / 6.f))))));
    const float ex = 1.f - __builtin_amdgcn_exp2f(x * 1.4426950408889634f);
    return x < -0.25f ? ex : pl; }
DI float log1p_small(float e) {
    const float pl = e * (1.f - e * (0.5f - e * ((1.f / 3.f) - e * (0.25f - e * 0.2f))));
    return e > 0.03f ? __logf(1.f + e) : pl; }
struct EpiGate {
    static constexpr bool PERM = false, AFTER_DRAIN = false;
    const bf16_t* UC; const float* gate_b; const float* lam; __half2* AB0; __half2* AB1;
    DI void operator()(const f32x4 (&acc)[2][2][4][2], const Unit& u, int wr, int wc, int fr, int fq) const {
        const int j2 = u.pn >> 2, d = (u.pn >> 1) & 1, half = u.pn & 1;
        const int row0 = u.pm * 256 + wr * 64 + fr, ch0 = j2 * 256 + half * 128 + wc * 32 + 4 * fq;
        __half2* AB = d ? AB1 : AB0;
        u32x2 ucv[2][2][4];
#pragma unroll
        for (int n = 0; n < 2; ++n)
#pragma unroll
            for (int ai = 0; ai < 2; ++ai)
#pragma unroll
                for (int m = 0; m < 4; ++m) ucv[n][ai][m] = *(const u32x2*)(UC + (size_t)(row0 + ai * 128 + m * 16) * DM + ch0 + 16 * n);
#pragma unroll
        for (int n = 0; n < 2; ++n) { const int ch = ch0 + 16 * n;
            const f32x4 gr = *(const f32x4*)(gate_b + (d * 2 + 0) * DM + ch), gi = *(const f32x4*)(gate_b + (d * 2 + 1) * DM + ch), l = *(const f32x4*)(lam + d * DM + ch);
            f32x4 c8;
#pragma unroll
            for (int i = 0; i < 4; ++i) c8[i] = -8.f * log1p_small(__expf(-l[i]));
#pragma unroll
            for (int ai = 0; ai < 2; ++ai)
#pragma unroll
                for (int m = 0; m < 4; ++m) { const size_t rowoff = (size_t)(row0 + ai * 128 + m * 16) * DM;
                    const u32x2 uu = ucv[n][ai][m]; const float uv[4] = {bflo(uu[0]), bfhi(uu[0]), bflo(uu[1]), bfhi(uu[1])};
                    unsigned o[4];
#pragma unroll
                    for (int i = 0; i < 4; ++i) { const float rr = sigm(acc[ai][0][m][n][i] + gr[i]), ii = sigm(acc[ai][1][m][n][i] + gi[i]);
                        const float la = c8[i] * rr; const float bv = __builtin_amdgcn_sqrtf(neg_expm1(2.f * la)) * ii * uv[i]; o[i] = __builtin_bit_cast(unsigned, __floats2half2_rn(la, bv)); }
                    *(u32x4*)(AB + rowoff + ch) = (u32x4){o[0], o[1], o[2], o[3]}; } }
    }
};
struct EpiQ {
    static constexpr bool PERM = true, AFTER_DRAIN = false;
    bf16_t* Q; const float* rope;
    DI void operator()(const f32x4 (&acc)[2][2][4][2], const Unit& u, int wr, int wc, int fr, int fq) const {
        const int row0 = u.pm * 256 + wr * 64 + fr;
#pragma unroll
        for (int bj = 0; bj < 2; ++bj) { const int c0 = u.pn * 256 + bj * 128 + wc * 32 + 8 * fq; const int h = c0 / 192, d0 = c0 - h * 192;
            const bool isrope = d0 >= 128; const int g = (d0 - 128) >> 3;
#pragma unroll
            for (int ai = 0; ai < 2; ++ai)
#pragma unroll
                for (int m = 0; m < 4; ++m) { const int row = row0 + ai * 128 + m * 16; f32x4 v0 = acc[ai][bj][m][0], v1 = acc[ai][bj][m][1];
                    if (isrope) { const int t = row & 4095, pos = (g >> 2) ? (t & 63) : (t >> 6);
                        const f32x4 cs0 = *(const f32x4*)(rope + (pos * 16 + 4 * (g & 3)) * 2), cs1 = *(const f32x4*)(rope + (pos * 16 + 4 * (g & 3)) * 2 + 4);
                        const float cc[4] = {cs0[0], cs0[2], cs1[0], cs1[2]}, sn[4] = {cs0[1], cs0[3], cs1[1], cs1[3]};
#pragma unroll
                        for (int i = 0; i < 4; ++i) { const float a = v0[i], b = v1[i]; v0[i] = a * cc[i] - b * sn[i]; v1[i] = a * sn[i] + b * cc[i]; } }
                    v0 *= QSCALE; v1 *= QSCALE;
                    *(u32x4*)(Q + (size_t)row * 1536 + c0) = (u32x4){pk2(v0[0], v0[1]), pk2(v0[2], v0[3]), pk2(v1[0], v1[1]), pk2(v1[2], v1[3])}; } }
    }
};
struct EpiVT {
    static constexpr bool PERM = false, AFTER_DRAIN = false;
    bf16_t* VT;
    DI void operator()(const f32x4 (&acc)[2][2][4][2], const Unit& u, int wr, int wc, int fr, int fq) const {
        const int f0 = u.pm * 256 + wr * 64 + fr;
#pragma unroll
        for (int bj = 0; bj < 2; ++bj)
#pragma unroll
            for (int n = 0; n < 2; ++n) { const int tok = u.pn * 256 + bj * 128 + wc * 32 + 16 * n + 4 * fq;
                int b, key; if (tok < ML) { b = tok >> 12; key = 256 + (tok & 4095); } else { b = (tok - ML) >> 8; key = (tok - ML) & 255; }
                const int qi = (key >> 2) & 3, pos = (key & ~15) + 4 * (((qi & 1) << 1) | (qi >> 1));
#pragma unroll
                for (int ai = 0; ai < 2; ++ai)
#pragma unroll
                    for (int m = 0; m < 4; ++m) { const int f = f0 + ai * 128 + m * 16; const f32x4 v = acc[ai][bj][m][n];
                        *(u32x2*)(VT + ((size_t)(b * 1024 + f)) * NKEY + pos) = (u32x2){pk2(v[0], v[1]), pk2(v[2], v[3])}; } }
    }
};
struct WD { const float* src; bf16_t* dst; int Np, K, kind, lds, nvalid; };
template <int KIND> DI float wfetch(const WD& w, int n, int k) {
    if constexpr (KIND == 6) { const int pn = n >> 8, bj = (n >> 7) & 1, jj = n & 127, j2 = pn >> 2, d = (pn >> 1) & 1, half = pn & 1;
        const float v = w.src[((((d * 2 + bj) * 8 + (2 * j2 + half)) * 128 + (k & 127)) * 128) + jj];
        return (k >> 7) != half ? 0.f : v; }
    else {
        int col; bool valid = true;
        if constexpr (KIND == 0) { valid = n < w.nvalid; col = valid ? n : 0; }
        else if constexpr (KIND == 1) col = ((n >> 7) & 1) * DFF + (n >> 8) * 128 + (n & 127);
        else if constexpr (KIND == 3) { const int h = n / 192, d = n - h * 192; col = d < 128 ? n : h * 192 + 128 + rope_orig(d < 128 ? 0 : d - 128); }
        else if constexpr (KIND == 4) col = (n >> 7) * 256 + (n & 127);
        else col = (n >> 7) * 256 + 128 + (n & 127);
        const float v = w.src[(size_t)k * w.lds + col];
        return valid ? v : 0.f; }
}
template <int KIND> DI void convert_weight(const WD& w, float* tile  ) {
    const int tid = tid_l(), lane = tid & 63, wv = tid >> 6;
    const int tk = w.K >> 6, ntile = (w.Np >> 6) * tk;
    for (int t = bid_l(); t < ntile; t += gridDim.x) {
        const int n0 = (t / tk) << 6, k0 = (t % tk) << 6;
#pragma unroll
        for (int i = 0; i < 8; ++i) { const int kl = i * 8 + wv; tile[kl * 65 + lane] = wfetch<KIND>(w, n0 + lane, k0 + kl); }
        __syncthreads();
        { const int nl = tid >> 3, kc = tid & 7; float v[8];
#pragma unroll
          for (int j = 0; j < 8; ++j) v[j] = tile[(kc * 8 + j) * 65 + nl];
          *(u32x4*)(w.dst + (size_t)(n0 + nl) * w.K + k0 + kc * 8) = (u32x4){pk2(v[0], v[1]), pk2(v[2], v[3]), pk2(v[4], v[5]), pk2(v[6], v[7])}; }
        __syncthreads();
    }
}
DI WD mkwd(const float* src, unsigned char* ws, size_t off, int Np, int K, int kind, int lds, int nvalid) { WD w; w.src = src; w.dst = (bf16_t*)(ws + off); w.Np = Np; w.K = K; w.kind = kind; w.lds = lds; w.nvalid = nvalid; return w; }
template <class P> DI void convert_set_a(const P& p, float* tile) {
    for (int s = 0; s < 2; ++s) {
        convert_weight<1>(mkwd(p.in(I_FIN0) + (size_t)s * 1024 * 5632, p.ws, OFF_WIN0 + s * SZ_WIN, 5632, 1024, 1, 5632, 5632), tile);
        convert_weight<0>(mkwd(p.in(I_FOUT0) + (size_t)s * DFF * 1024, p.ws, OFF_WOUT0 + s * SZ_WOUT, 1024, DFF, 0, 1024, 1024), tile); }
    convert_weight<0>(mkwd(p.in(I_RGIN), p.ws, OFF_RGIN, 2048, 1024, 0, 2048, 2048), tile);
    convert_weight<0>(mkwd(p.in(I_RGOUT), p.ws, OFF_RGOUT, 1024, 1024, 0, 1024, 1024), tile);
    convert_weight<6>(mkwd(p.in(I_GATEW), p.ws, OFF_GATE, 4096, 256, 6, 0, 0), tile);
}
template <class P> DI void convert_set_b(const P& p, float* tile) {
    for (int s = 0; s < 2; ++s) {
        convert_weight<1>(mkwd(p.in(I_FIN1) + (size_t)s * 1024 * 5632, p.ws, OFF_WIN1 + s * SZ_WIN, 5632, 1024, 1, 5632, 5632), tile);
        convert_weight<0>(mkwd(p.in(I_FOUT1) + (size_t)s * DFF * 1024, p.ws, OFF_WOUT1 + s * SZ_WOUT, 1024, DFF, 0, 1024, 1024), tile); }
    convert_weight<0>(mkwd(p.in(I_WA), p.ws, OFF_WA, 1024, 1024, 0, 832, 832), tile);
    convert_weight<3>(mkwd(p.in(I_WQB), p.ws, OFF_WQB, 1536, 512, 3, 1536, 1536), tile);
    convert_weight<4>(mkwd(p.in(I_WKVB), p.ws, OFF_WKN, 1024, 256, 4, 2048, 2048), tile);
    convert_weight<5>(mkwd(p.in(I_WKVB), p.ws, OFF_WV, 1024, 256, 5, 2048, 2048), tile);
    convert_weight<0>(mkwd(p.in(I_WO), p.ws, OFF_WO, 1024, 1024, 0, 1024, 1024), tile);
}
DI void prologue_phase(const Params& p, float* lds) {
    const int tid = tid_l(), lane = tid & 63, wv = tid >> 6;
    float* sv = lds;
    float* red = lds + 5 * 1024;
    float* tile = red + 8 * 5 * 64;
    for (int i = tid; i < 5 * 1024; i += 512) { const float v = i < 4096 ? p.in(I_C)[i] : p.in(I_CCTX)[i - 4096]; sv[i] = v * sigm(v); }
    __syncthreads();
    float* MOD = (float*)(p.ws + OFF_MOD);
    for (int it = bid_l(); it < 288; it += gridDim.x) {
        const int layer = it / 144, col = (it % 144) * 64 + lane; const float* W = layer ? p.in(I_MODW1) : p.in(I_MODW0); const float* MB = layer ? p.in(I_MODB1) : p.in(I_MODB0);
        float a0 = 0.f, a1 = 0.f, a2 = 0.f, a3 = 0.f, a4 = 0.f;
#pragma unroll 32
        for (int kk = 0; kk < 128; ++kk) { const int k = wv * 128 + kk; const float w = W[(size_t)k * 9216 + col];
            a0 += sv[k] * w; a1 += sv[1024 + k] * w; a2 += sv[2048 + k] * w; a3 += sv[3072 + k] * w; a4 += sv[4096 + k] * w; }
        red[(wv * 5 + 0) * 64 + lane] = a0; red[(wv * 5 + 1) * 64 + lane] = a1; red[(wv * 5 + 2) * 64 + lane] = a2; red[(wv * 5 + 3) * 64 + lane] = a3; red[(wv * 5 + 4) * 64 + lane] = a4;
        __syncthreads();
        if (tid < 320) { const int v = tid >> 6; float s = 0.f;
#pragma unroll
            for (int w8 = 0; w8 < 8; ++w8) s += red[(w8 * 5 + v) * 64 + lane];
            MOD[(size_t)(layer * 5 + v) * 9216 + col] = s + MB[col]; }
        __syncthreads();
    }
    if (bid_l() == gridDim.x - 1 && tid < 16) {
        double th = 1.0; for (int i = 0; i < tid; ++i) th *= 0.56234132519034908;
        double c1 = 1.0, s1 = th, tc = 1.0, ts = th; const double t2 = th * th;
        for (int n = 1; n <= 12; ++n) { tc *= -t2 / (double)((2 * n - 1) * (2 * n)); ts *= -t2 / (double)((2 * n) * (2 * n + 1)); c1 += tc; s1 += ts; }
        double cc = 1.0, ss = 0.0; float* RT = (float*)(p.ws + OFF_ROPE);
        for (int pos = 0; pos < 64; ++pos) { RT[(pos * 16 + tid) * 2] = (float)cc; RT[(pos * 16 + tid) * 2 + 1] = (float)ss; const double nc = cc * c1 - ss * s1, ns = cc * s1 + ss * c1; cc = nc; ss = ns; }
    }
    if (tid < 27) ((const float**)(p.ws + OFF_TAB))[tid] = p.in(tid);
    convert_set_a(p, tile);
}

struct RowD { int first, pl, psub, pg, pw2, has_next, nl, nsub, ng, M, nsplit; };
template <bool FIRST, bool HASNEXT> DI void row_phase_t(const Ctx& p, const RowD d) {
    const int tid = tid_l(), lane = tid & 63, wv = tid >> 6;
    const float* MOD = (const float*)(p.ws + OFF_MOD); float* XC = (float*)(p.ws + OFF_XC);
    bf16_t* Y = (bf16_t*)(p.ws + OFF_Y);
    const float pw = 0.5f * (float)d.pw2;
    const float* gpost = (d.pl ? p.in(I_NORMG1) : p.in(I_NORMG0)) + d.pg * DM; const float* gpre = (d.nl ? p.in(I_NORMG1) : p.in(I_NORMG0)) + d.ng * DM;
    int mb_have = -1; f32x4 cpost[4], cpre[4], shf[4];
#pragma unroll
    for (int j = 0; j < 4; ++j) { cpost[j] = (f32x4){0.f, 0.f, 0.f, 0.f}; cpre[j] = cpost[j]; shf[j] = cpost[j]; }
    const int nw = (int)gridDim.x * 8, gw = bid_l() * 8 + wv;
    const int lo = (gw * ML) / nw, hi = ((gw + 1) * ML) / nw, nlat = hi - lo;
    const int nctx = d.M > ML ? (d.M - ML - gw + nw - 1) / nw : 0;
    const int ntot = nlat + (nctx > 0 ? nctx : 0);
    for (int it = 0; it < ntot; ++it) {
        const int r = it < nlat ? lo + it : ML + gw + (it - nlat) * nw;
        const int mb = r < ML ? (r >> 12) : 4;
        float* xs = r < ML ? p.out + (size_t)r * DM : XC + (size_t)(r - ML) * DM;
        const float* xin = FIRST ? (r < ML ? p.in(I_X) + (size_t)r * DM : p.in(I_CTX) + (size_t)(r - ML) * DM) : xs;
        f32x4 xv[4]; u32x2 yv[4];
#pragma unroll
        for (int j = 0; j < 4; ++j) { xv[j] = *(const f32x4*)(xin + 256 * j + 4 * lane); yv[j] = (u32x2){0u, 0u}; }
        const bool ypart = r >= ML && d.nsplit > 0;
        if (!FIRST && !ypart) {
#pragma unroll
            for (int j = 0; j < 4; ++j) yv[j] = *(const u32x2*)(Y + (size_t)r * DM + 256 * j + 4 * lane); }
        if (mb != mb_have) { mb_have = mb;
            const float* gt = MOD + (size_t)(d.pl * 5 + mb) * 9216 + d.psub * 3072 + 2048; const float* sh = MOD + (size_t)(d.nl * 5 + mb) * 9216 + d.nsub * 3072; const float* sc = sh + 1024;
            { f32x4 a0[4], a1[4];
#pragma unroll
              for (int j = 0; j < 4; ++j) { const int c = 256 * j + 4 * lane; a0[j] = *(const f32x4*)(gpost + c); a1[j] = *(const f32x4*)(gt + c); }
#pragma unroll
              for (int j = 0; j < 4; ++j) cpost[j] = a0[j] * a1[j] * pw; }
            { f32x4 a2[4], a3[4];
#pragma unroll
              for (int j = 0; j < 4; ++j) { const int c = 256 * j + 4 * lane; a2[j] = *(const f32x4*)(gpre + c); a3[j] = *(const f32x4*)(sc + c); shf[j] = *(const f32x4*)(sh + c); }
#pragma unroll
              for (int j = 0; j < 4; ++j) cpre[j] = a2[j] * (1.f + a3[j]); } }
        if (!FIRST) {
            f32x4 yf[4]; float ss = 0.f;
            if (ypart) {
                const float* P = (const float*)(p.ws + OFF_PART) + (size_t)(r - ML) * 1024;
#pragma unroll
                for (int j = 0; j < 4; ++j) { f32x4 a;
                    if (d.nsplit == 11) { f32x4 pv[11];
#pragma unroll
                        for (int s = 0; s < 11; ++s) pv[s] = *(const f32x4*)(P + (size_t)s * 1024 * 1024 + 256 * j + 4 * lane);
                        a = pv[0];
#pragma unroll
                        for (int s = 1; s < 11; ++s) a += pv[s]; }
                    else { a = *(const f32x4*)(P + 256 * j + 4 * lane);
                        for (int s = 1; s < d.nsplit; ++s) a += *(const f32x4*)(P + (size_t)s * 1024 * 1024 + 256 * j + 4 * lane); }
                    yf[j] = a; }
            } else {
#pragma unroll
                for (int j = 0; j < 4; ++j) yf[j] = (f32x4){bflo(yv[j][0]), bfhi(yv[j][0]), bflo(yv[j][1]), bfhi(yv[j][1])};
            }
#pragma unroll
            for (int j = 0; j < 4; ++j) ss += yf[j][0] * yf[j][0] + yf[j][1] * yf[j][1] + yf[j][2] * yf[j][2] + yf[j][3] * yf[j][3];
            ss = wave_sum(ss); const float rstd = rsqrtf(ss * (1.f / 1024.f) + 1e-6f);
#pragma unroll
            for (int j = 0; j < 4; ++j) xv[j] += cpost[j] * rstd * yf[j];
        }
#pragma unroll
        for (int j = 0; j < 4; ++j) *(f32x4*)(xs + 256 * j + 4 * lane) = xv[j];
        if (HASNEXT) {
            float ss = 0.f;
#pragma unroll
            for (int j = 0; j < 4; ++j) ss += xv[j][0] * xv[j][0] + xv[j][1] * xv[j][1] + xv[j][2] * xv[j][2] + xv[j][3] * xv[j][3];
            ss = wave_sum(ss); const float rstd = rsqrtf(ss * (1.f / 1024.f) + 1e-6f);
            bf16_t* xn = (bf16_t*)(p.ws + OFF_XN) + (size_t)r * DM;
#pragma unroll
            for (int j = 0; j < 4; ++j) { const f32x4 o = xv[j] * rstd * cpre[j] + shf[j];
                *(u32x2*)(xn + 256 * j + 4 * lane) = (u32x2){pk2(o[0], o[1]), pk2(o[2], o[3])}; }
        }
    }
}

DI void row_phase(const Ctx& p, const RowD d) {
    if (d.first) row_phase_t<true, true>(p, d);
    else if (d.has_next) row_phase_t<false, true>(p, d);
    else row_phase_t<false, false>(p, d);
}

DI void conv_phase(const Ctx& p) {
    const bf16_t* U = (const bf16_t*)(p.ws + OFF_U); bf16_t* UC = (bf16_t*)(p.ws + OFF_UC); const float* cb_ = p.in(I_CONVB); const float* cw_ = p.in(I_CONVW);
    const int idx0 = bid_l() * 512 + tid_l(), c8 = (idx0 & 127) * 8;
    float w[4][8], bb[8];
    { const f32x4 b0 = *(const f32x4*)(cb_ + c8), b1 = *(const f32x4*)(cb_ + c8 + 4); bb[0] = b0[0]; bb[1] = b0[1]; bb[2] = b0[2]; bb[3] = b0[3]; bb[4] = b1[0]; bb[5] = b1[1]; bb[6] = b1[2]; bb[7] = b1[3]; }
#pragma unroll
    for (int k = 0; k < 4; ++k) { const f32x4 w0 = *(const f32x4*)(cw_ + k * DM + c8), w1 = *(const f32x4*)(cw_ + k * DM + c8 + 4);
        w[k][0] = w0[0]; w[k][1] = w0[1]; w[k][2] = w0[2]; w[k][3] = w0[3]; w[k][4] = w1[0]; w[k][5] = w1[1]; w[k][6] = w1[2]; w[k][7] = w1[3]; }
    const int step = gridDim.x * 512;
    for (int item = idx0; item < (MT / 8) * 128; item += step) {
        const int r0 = (item >> 7) * 8;
        int t0, Ls; if (r0 < ML) { t0 = r0 & 4095; Ls = 4096; } else { t0 = (r0 - ML) & 255; Ls = 256; }
        u32x4 uu[11];
#pragma unroll
        for (int i = 0; i < 11; ++i) { const int tt = t0 + i - 2; uu[i] = (u32x4){0u, 0u, 0u, 0u}; if (tt >= 0 && tt < Ls) uu[i] = *(const u32x4*)(U + (size_t)(r0 + i - 2) * DM + c8); }
#pragma unroll
        for (int q = 0; q < 8; ++q) { float a[8];
#pragma unroll
            for (int e = 0; e < 8; ++e) a[e] = bb[e];
#pragma unroll
            for (int k = 0; k < 4; ++k) { const u32x4 x = uu[q + k];
                a[0] += bflo(x[0]) * w[k][0]; a[1] += bfhi(x[0]) * w[k][1]; a[2] += bflo(x[1]) * w[k][2]; a[3] += bfhi(x[1]) * w[k][3];
                a[4] += bflo(x[2]) * w[k][4]; a[5] += bfhi(x[2]) * w[k][5]; a[6] += bflo(x[3]) * w[k][6]; a[7] += bfhi(x[3]) * w[k][7]; }
            *(u32x4*)(UC + (size_t)(r0 + q) * DM + c8) = (u32x4){pk2(a[0], a[1]), pk2(a[2], a[3]), pk2(a[4], a[5]), pk2(a[6], a[7])}; }
    }
}
constexpr int CHK = 32, NCK = 136, NSCAN_ITEMS = 4 * NCK * 4;
DI int chunk_row(int b, int k) { return k < 8 ? ML + b * 256 + CHK * k : b * 4096 + CHK * (k - 8); }
#define SCAN_LOAD(it) do { const int cg_ = (it) & 3, bk_ = (it) >> 2, b_ = bk_ / NCK, k_ = bk_ - b_ * NCK; const size_t ro_ = ((size_t)chunk_row(b_, k_) * DM + cg_ * 256) * 4; \
        const unsigned char* A0_ = p.ws + OFF_AB0 + ro_; const unsigned char* A1_ = p.ws + OFF_AB1 + ro_; \
        _Pragma("unroll") for (int i = 0; i < 4; ++i) { const int idx = tid + 512 * i, row = idx >> 6, c16 = idx & 63; \
            ta[i] = *(const u32x4*)(A0_ + (size_t)row * 4096 + c16 * 16); tb[i] = *(const u32x4*)(A1_ + (size_t)row * 4096 + c16 * 16); } } while (0)
#define SCAN_WRITE() do { _Pragma("unroll") for (int i = 0; i < 4; ++i) { const int idx = tid + 512 * i, row = idx >> 6, c16 = idx & 63; \
            *(LAS u32x4*)(lds + row * 1024 + c16 * 16) = ta[i]; *(LAS u32x4*)(lds + 32768 + row * 1024 + c16 * 16) = tb[i]; } } while (0)
DI void scan1_phase(const Ctx& p, LAS unsigned char* lds) {
    const int tid = tid_l(); f32x2* CAR = (f32x2*)(p.ws + OFF_CAR);
    u32x4 ta[4], tb[4];
    int item = bid_l();
    if (item < NSCAN_ITEMS) SCAN_LOAD(item);
    while (item < NSCAN_ITEMS) {
        const int cg = item & 3, bk = item >> 2, b = bk / NCK, k = bk - b * NCK;
        SCAN_WRITE();
        __syncthreads();
        const int nxt = item + (int)gridDim.x;
        if (nxt < NSCAN_ITEMS) SCAN_LOAD(nxt);
        { const int dir = tid >> 8, c = tid & 255; const LAS unsigned char* tl = lds + dir * 32768 + c * 4; float P = 0.f, h = 0.f;
#pragma unroll
          for (int s = 0; s < CHK; ++s) { const int t = dir ? CHK - 1 - s : s; const float2 v = __half22float2(__builtin_bit_cast(__half2, *(const LAS unsigned*)(tl + t * 1024))); P += v.x; h = __expf(v.x) * h + v.y; }
          CAR[(size_t)((dir * 4 + b) * NCK + k) * 1024 + cg * 256 + c] = (f32x2){P, h}; }
        __syncthreads();
        item = nxt;
    }
}
DI void scan3_phase(const Ctx& p, LAS unsigned char* lds) {
    const int tid = tid_l(); const f32x2* CAR = (const f32x2*)(p.ws + OFF_CAR);
    bf16_t* YG = (bf16_t*)(p.ws + OFF_YG);
    u32x4 ta[4], tb[4], ty[2];
#define SCAN_LOADY(it) do { const int cg_ = (it) & 3, bk_ = (it) >> 2, b_ = bk_ / NCK, k_ = bk_ - b_ * NCK, r0_ = chunk_row(b_, k_); \
        _Pragma("unroll") for (int i = 0; i < 2; ++i) { const int idx = tid + 512 * i, row = idx >> 5, c16 = idx & 31; ty[i] = *(const u32x4*)(YG + (size_t)(r0_ + row) * DM + cg_ * 256 + c16 * 8); } } while (0)
    int item = bid_l();
    if (item < NSCAN_ITEMS) { SCAN_LOAD(item); SCAN_LOADY(item); }
    while (item < NSCAN_ITEMS) {
        const int cg = item & 3, bk = item >> 2, b = bk / NCK, k = bk - b * NCK, row0 = chunk_row(b, k);
        SCAN_WRITE();
#pragma unroll
        for (int i = 0; i < 2; ++i) { const int idx = tid + 512 * i, row = idx >> 5, c16 = idx & 31; *(LAS u32x4*)(lds + 65536 + row * 512 + c16 * 16) = ty[i]; }
        const int dir = tid >> 8, c = tid & 255; float h = 0.f;
        { const f32x2* C = CAR + (size_t)((dir * 4 + b) * NCK) * 1024 + cg * 256 + c;
          const int npre = dir == 0 ? k : (k < 8 ? 7 - k : NCK + 7 - k);
          for (int q0 = 0; q0 < npre; q0 += 16) { f32x2 cv[16];
#pragma unroll
              for (int j = 0; j < 16; ++j) { const int q = q0 + j, kk = dir == 0 ? q : (q < 8 ? 7 - q : NCK + 7 - q); cv[j] = q < npre ? C[(size_t)kk * 1024] : (f32x2){0.f, 0.f}; }
#pragma unroll
              for (int j = 0; j < 16; ++j) h = __expf(cv[j][0]) * h + cv[j][1]; } }
        __syncthreads();
        const int nxt = item + (int)gridDim.x;
        if (nxt < NSCAN_ITEMS) { SCAN_LOAD(nxt); SCAN_LOADY(nxt); }
        { LAS unsigned char* tl = lds + dir * 32768 + c * 4;
#pragma unroll
          for (int s = 0; s < CHK; ++s) { const int t = dir ? CHK - 1 - s : s; const float2 v = __half22float2(__builtin_bit_cast(__half2, *(const LAS unsigned*)(tl + t * 1024))); h = __expf(v.x) * h + v.y; *(LAS float*)(tl + t * 1024) = h; } }
        __syncthreads();
#pragma unroll
        for (int i = 0; i < 8; ++i) { const int idx = tid + 512 * i, row = idx >> 7, cp = idx & 127;
            const f32x2 hf = *(const LAS f32x2*)(lds + row * 1024 + cp * 8), hr = *(const LAS f32x2*)(lds + 32768 + row * 1024 + cp * 8); const unsigned yg = *(const LAS unsigned*)(lds + 65536 + row * 512 + cp * 4);
            *(unsigned*)(YG + (size_t)(row0 + row) * DM + cg * 256 + cp * 2) = pk2((hf[0] + hr[0]) * bflo(yg), (hf[1] + hr[1]) * bfhi(yg)); }
        __syncthreads();
        item = nxt;
    }
#undef SCAN_LOADY
}
#undef SCAN_LOAD
#undef SCAN_WRITE

DI void mla_norm_phase(const Ctx& p) {
    const int tid = tid_l(), lane = tid & 63, wv = tid >> 6;
    const bf16_t* CA = (const bf16_t*)(p.ws + OFF_CA); bf16_t* CQ = (bf16_t*)(p.ws + OFF_CQ); bf16_t* CKV = (bf16_t*)(p.ws + OFF_CKV); bf16_t* KR = (bf16_t*)(p.ws + OFF_KR);
    const float* RT = (const float*)(p.ws + OFF_ROPE);
    const f32x4 gkv = *(const f32x4*)(p.in(I_KVNORM) + 4 * lane), gq0 = *(const f32x4*)(p.in(I_QNORM) + 8 * lane), gq1 = *(const f32x4*)(p.in(I_QNORM) + 8 * lane + 4);
    const int o = rope_orig(lane);
    const int nw = (int)gridDim.x * 8, gw = bid_l() * 8 + wv;
    for (int r = (gw * ML) / nw; r < ((gw + 1) * ML) / nw; ++r) {
        const bf16_t* row = CA + (size_t)r * DM;
        const u32x2 kv = *(const u32x2*)(row + 512 + 4 * lane); const bf16_t vraw = row[768 + o];
        const u32x4 qv = *(const u32x4*)(row + 8 * lane); const bf16_t vpraw = row[768 + (o ^ 16)];
        const int t = r & 4095, pos = (o < 32) ? (t >> 6) : (t & 63); const f32x2 csn = *(const f32x2*)(RT + (pos * 16 + (o & 15)) * 2);
        const float k0 = bflo(kv[0]), k1 = bfhi(kv[0]), k2 = bflo(kv[1]), k3 = bfhi(kv[1]);
        float q[8] = {bflo(qv[0]), bfhi(qv[0]), bflo(qv[1]), bfhi(qv[1]), bflo(qv[2]), bfhi(qv[2]), bflo(qv[3]), bfhi(qv[3])};
        float ssq = 0.f;
#pragma unroll
        for (int i = 0; i < 8; ++i) ssq += q[i] * q[i];
        const float sskv = wave_sum(k0 * k0 + k1 * k1 + k2 * k2 + k3 * k3); ssq = wave_sum(ssq);
        const float rkv = rsqrtf(sskv * (1.f / 256.f) + 1e-6f), rq = rsqrtf(ssq * (1.f / 512.f) + 1e-6f);
        *(u32x2*)(CKV + (size_t)r * 256 + 4 * lane) = (u32x2){pk2(k0 * rkv * gkv[0], k1 * rkv * gkv[1]), pk2(k2 * rkv * gkv[2], k3 * rkv * gkv[3])};
        *(u32x4*)(CQ + (size_t)r * 512 + 8 * lane) = (u32x4){pk2(q[0] * rq * gq0[0], q[1] * rq * gq0[1]), pk2(q[2] * rq * gq0[2], q[3] * rq * gq0[3]), pk2(q[4] * rq * gq1[0], q[5] * rq * gq1[1]), pk2(q[6] * rq * gq1[2], q[7] * rq * gq1[3])};
        const float v = bf1(vraw), vp = bf1(vpraw), cs = csn[0], sn = csn[1];
        const float kr = (o & 16) ? vp * sn + v * cs : v * cs - vp * sn;
        KR[(size_t)r * 64 + lane] = (bf16_t)(pk2(kr, 0.f) & 0xffffu);
    }
    for (int r = ML + gw; r < MT; r += nw) {
        const bf16_t* row = CA + (size_t)r * DM;
        const u32x2 kv = *(const u32x2*)(row + 512 + 4 * lane); const bf16_t vraw = row[768 + o];
        const float k0 = bflo(kv[0]), k1 = bfhi(kv[0]), k2 = bflo(kv[1]), k3 = bfhi(kv[1]);
        const float ss = wave_sum(k0 * k0 + k1 * k1 + k2 * k2 + k3 * k3), rstd = rsqrtf(ss * (1.f / 256.f) + 1e-6f);
        *(u32x2*)(CKV + (size_t)r * 256 + 4 * lane) = (u32x2){pk2(k0 * rstd * gkv[0], k1 * rstd * gkv[1]), pk2(k2 * rstd * gkv[2], k3 * rstd * gkv[3])};
        KR[(size_t)r * 64 + lane] = vraw;
    }
}

constexpr int KNB = 0, KRB = 16384, VTB = 24576, ABUF = 40960;
DI void attn_phase(const Ctx& p, LAS unsigned char* lds) {
    const int tid = tid_l(), lane = tid & 63, wv = __builtin_amdgcn_readfirstlane(tid >> 6), ql = lane & 31, hi = lane >> 5;
    const bf16_t* Q = (const bf16_t*)(p.ws + OFF_Q); const bf16_t* KN = (const bf16_t*)(p.ws + OFF_KN); const bf16_t* KR = (const bf16_t*)(p.ws + OFF_KR); const bf16_t* VT = (const bf16_t*)(p.ws + OFF_VT);
    bf16_t* O = (bf16_t*)(p.ws + OFF_O);
    unsigned okn[2], ovt[2], okr;
#pragma unroll
    for (int e = 0; e < 2; ++e) { const int P = (2 * wv + e) * 64 + lane; { const int row = P >> 4, c = (P & 15) ^ (row & 15); okn[e] = (unsigned)(row * 1024 + c * 8); }
        { const int row = P >> 3, c = (P & 7) ^ ((row >> 1) & 7); ovt[e] = (unsigned)(row * NKEY + c * 8); } }
    { const int P = wv * 64 + lane, row = P >> 3, c = (P & 7) ^ ((row >> 1) & 7); okr = (unsigned)(row * 64 + c * 8); }
    const int zk = hi ^ (ql & 15), zr = hi ^ ((ql >> 1) & 7);
    const int rdkn = KNB + ql * 256, rdkr = KRB + ql * 128, rdvt = VTB + ql * 128;
    for (int item = bid_l(); item < 512; item += gridDim.x) {
        const int xcd = item & 7, slot = (item >> 3) & 31, rr = item >> 8, bh = xcd * 2 + (slot >> 4) + 16 * rr, qb = slot & 15, b = bh >> 3, h = bh & 7;
        const int r0 = b * 4096 + qb * 256 + wv * 32 + ql;
        bf16x8 qf[12];
#pragma unroll
        for (int s = 0; s < 12; ++s) qf[s] = *(const bf16x8*)(Q + (size_t)r0 * 1536 + h * 192 + 16 * s + 8 * hi);
        f32x16 oacc[4];
#pragma unroll
        for (int dt = 0; dt < 4; ++dt)
#pragma unroll
            for (int i = 0; i < 16; ++i) oacc[dt][i] = 0.f;
        float mrow = -3.0e38f, lrow = 0.f;
        const bf16_t* vbase = VT + ((size_t)(b * 1024 + h * 128)) * NKEY;
#define ATT_DMA(j, buf) do { const int kb_ = (j) < 4 ? ML + b * 256 + 64 * (j) : b * 4096 + 64 * ((j) - 4); LAS unsigned char* sb_ = lds + (buf) * ABUF; \
            const bf16_t* kn_ = KN + (size_t)kb_ * 1024 + h * 128; const bf16_t* kr_ = KR + (size_t)kb_ * 64; const bf16_t* vt_ = vbase + 64 * (j); \
            __builtin_amdgcn_global_load_lds((const unsigned*)(kn_ + okn[0]), (LAS unsigned*)(sb_ + KNB + (2 * wv) * 1024), 16, 0, 0); \
            __builtin_amdgcn_global_load_lds((const unsigned*)(kn_ + okn[1]), (LAS unsigned*)(sb_ + KNB + (2 * wv + 1) * 1024), 16, 0, 0); \
            __builtin_amdgcn_global_load_lds((const unsigned*)(kr_ + okr), (LAS unsigned*)(sb_ + KRB + wv * 1024), 16, 0, 0); \
            __builtin_amdgcn_global_load_lds((const unsigned*)(vt_ + ovt[0]), (LAS unsigned*)(sb_ + VTB + (2 * wv) * 1024), 16, 0, 0); \
            __builtin_amdgcn_global_load_lds((const unsigned*)(vt_ + ovt[1]), (LAS unsigned*)(sb_ + VTB + (2 * wv + 1) * 1024), 16, 0, 0); } while (0)
        f32x16 s0, s1; bf16x8 pf[2][2];
#define KOFF(s) ((s) < 8 ? rdkn + (((2 * (s)) ^ zk) << 4) : rdkr + (((2 * ((s) - 8)) ^ zr) << 4))
#define KOFF1(s) ((s) < 8 ? 32 * 256 : 32 * 128)
#define VOFF(i) (rdvt + ((i) & 3) * 32 * 128 + (((2 * ((i) >> 2)) ^ zr) << 4))
#define ATT_X(sb) do { _Pragma("unroll") for (int i = 0; i < 16; ++i) { s0[i] = 0.f; s1[i] = 0.f; } \
            bf16x8 ka[3][2]; \
            _Pragma("unroll") for (int s = 0; s < 2; ++s) { ka[s][0] = *(const LAS bf16x8*)((sb) + KOFF(s)); ka[s][1] = *(const LAS bf16x8*)((sb) + KOFF(s) + KOFF1(s)); } \
            _Pragma("unroll") for (int s = 0; s < 12; ++s) { \
                if (s + 2 < 12) { ka[(s + 2) % 3][0] = *(const LAS bf16x8*)((sb) + KOFF(s + 2)); ka[(s + 2) % 3][1] = *(const LAS bf16x8*)((sb) + KOFF(s + 2) + KOFF1(s + 2)); } \
                s0 = __builtin_amdgcn_mfma_f32_32x32x16_bf16(ka[s % 3][0], qf[s], s0, 0, 0, 0); s1 = __builtin_amdgcn_mfma_f32_32x32x16_bf16(ka[s % 3][1], qf[s], s1, 0, 0, 0); \
                __builtin_amdgcn_sched_barrier(0); } } while (0)
#define ATT_Y() do { float mx = s0[0]; \
            _Pragma("unroll") for (int i = 1; i < 16; ++i) mx = fmaxf(mx, s0[i]); \
            _Pragma("unroll") for (int i = 0; i < 16; ++i) mx = fmaxf(mx, s1[i]); \
            { const auto rr_ = __builtin_amdgcn_permlane32_swap(__float_as_uint(mx), __float_as_uint(mx), false, false); mx = fmaxf(__uint_as_float(rr_[0]), __uint_as_float(rr_[1])); }     \
            const float mnew = fmaxf(mrow, mx); \
            if (__builtin_amdgcn_ballot_w64(mnew - mrow > 8.f) != 0ull) { const float alpha = __builtin_amdgcn_exp2f(mrow - mnew); lrow *= alpha; mrow = mnew;     \
                _Pragma("unroll") for (int dt = 0; dt < 4; ++dt) _Pragma("unroll") for (int i = 0; i < 16; ++i) oacc[dt][i] *= alpha; } \
            const float mn = mrow; float ps = 0.f; \
            _Pragma("unroll") for (int i = 0; i < 16; ++i) { s0[i] = __builtin_amdgcn_exp2f(s0[i] - mn); s1[i] = __builtin_amdgcn_exp2f(s1[i] - mn); ps += s0[i] + s1[i]; } \
            lrow += ps; \
            __builtin_amdgcn_sched_barrier(0); \
            _Pragma("unroll") for (int s2 = 0; s2 < 2; ++s2) { \
                pf[0][s2] = __builtin_bit_cast(bf16x8, (u32x4){pk2(s0[8 * s2], s0[8 * s2 + 1]), pk2(s0[8 * s2 + 2], s0[8 * s2 + 3]), pk2(s0[8 * s2 + 4], s0[8 * s2 + 5]), pk2(s0[8 * s2 + 6], s0[8 * s2 + 7])}); \
                pf[1][s2] = __builtin_bit_cast(bf16x8, (u32x4){pk2(s1[8 * s2], s1[8 * s2 + 1]), pk2(s1[8 * s2 + 2], s1[8 * s2 + 3]), pk2(s1[8 * s2 + 4], s1[8 * s2 + 5]), pk2(s1[8 * s2 + 6], s1[8 * s2 + 7])}); } \
            __builtin_amdgcn_sched_barrier(0); } while (0)
#define ATT_Z(sb) do { bf16x8 va[5]; \
            _Pragma("unroll") for (int i = 0; i < 4; ++i) va[i] = *(const LAS bf16x8*)((sb) + VOFF(i)); \
            _Pragma("unroll") for (int i = 0; i < 16; ++i) { if (i + 4 < 16) va[(i + 4) % 5] = *(const LAS bf16x8*)((sb) + VOFF(i + 4)); \
                oacc[i & 3] = __builtin_amdgcn_mfma_f32_32x32x16_bf16(va[i % 5], pf[(i >> 3) & 1][(i >> 2) & 1], oacc[i & 3], 0, 0, 0); __builtin_amdgcn_sched_barrier(0); } } while (0)
#define ATT_SYNC() do { asm volatile("s_waitcnt vmcnt(0)" ::: "memory"); __syncthreads(); } while (0)
        ATT_DMA(0, 0); ATT_DMA(1, 1);
        asm volatile("s_waitcnt vmcnt(5)" ::: "memory"); __syncthreads();
        for (int j = 0; j < NCH; ++j) {
            if (j + 2 < NCH) ATT_DMA(j + 2, (j + 2) % 3);
            LAS unsigned char* sb = lds + (j % 3) * ABUF;
            ATT_X(sb); ATT_Y(); ATT_Z(sb);
            if (j + 2 < NCH) asm volatile("s_waitcnt vmcnt(5)" ::: "memory"); else asm volatile("s_waitcnt vmcnt(0)" ::: "memory");
            __syncthreads();
        }
#undef KOFF
#undef KOFF1
#undef VOFF
#undef ATT_X
#undef ATT_Y
#undef ATT_Z
#undef ATT_SYNC
#undef ATT_DMA
        const float inv = 1.f / (lrow + __shfl_xor(lrow, 32));
#pragma unroll
        for (int dt = 0; dt < 4; ++dt)
#pragma unroll
            for (int rg = 0; rg < 4; ++rg)
                *(u32x2*)(O + (size_t)r0 * DM + h * 128 + 32 * dt + 8 * rg + 4 * hi) = (u32x2){pk2(oacc[dt][4 * rg] * inv, oacc[dt][4 * rg + 1] * inv), pk2(oacc[dt][4 * rg + 2] * inv, oacc[dt][4 * rg + 3] * inv)};
    }
}
struct PD { int kind, sync, M, N, K, lda, ldb, ldo, agrp, rot; unsigned offA, offB, offO; int r[9]; };
enum { K_PRO = 0, K_ROW, K_GSWI, K_GSTORE, K_GRGIN, K_CONV, K_GGATE, K_S1, K_S3, K_MLAN, K_GQ, K_GVT, K_ATT, K_GPART };
#define BIGG (1 << 20)
#define ROWP(first, pl, psub, pg, pw2, hn, nl, nsub, ng, M, convb, nsplit) {K_ROW, 1, M, 0, 0, 0, 0, 0, convb, nsplit, 0u, 0u, 0u, {first, pl, psub, pg, pw2, hn, nl, nsub, ng}}
#define GEMMP(kind, sync, M, N, K, lda, ldb, ldo, agrp, rot, offA, offB, offO) {kind, sync, M, N, K, lda, ldb, ldo, agrp, rot, (unsigned)(offA), (unsigned)(offB), (unsigned)(offO), {0, 0, 0, 0, 0, 0, 0, 0, 0}}
#define MISCP(kind) {kind, 1, 0, 0, 0, 0, 0, 0, 0, 0, 0u, 0u, 0u, {0, 0, 0, 0, 0, 0, 0, 0, 0}}
#define G1P(offW, M) GEMMP(K_GSWI, 1, M, 5632, 1024, 1024, 1024, 2816, BIGG, 0, OFF_XN, offW, OFF_H)
#define G2P(offW, M) GEMMP(K_GSTORE, 1, M, 1024, 2816, 2816, 2816, 1024, BIGG, 0, OFF_H, offW, OFF_Y)
#define G2L(offA, offW, Kf, offO) GEMMP(K_GSTORE, 0, ML, 1024, Kf, Kf, Kf, 1024, BIGG, 0, offA, offW, offO)
#define G2C(offA, offW, Kf) GEMMP(K_GPART, 1, MC, 1024 * (Kf / 256), 256, Kf, Kf, 4, 4, 0, (offA) + (size_t)ML * (Kf) * 2, offW, 0)
constexpr int NPH = 32;
__device__ const PD PROG[NPH] = {
    MISCP(K_PRO),
    ROWP(1, 0, 0, 0, 0, 1, 0, 0, 0, MT, 0, 0),
    G1P(OFF_WIN0, MT), G2L(OFF_H, OFF_WOUT0, 2816, OFF_Y), G2C(OFF_H, OFF_WOUT0, 2816),
    ROWP(0, 0, 0, 1, 1, 1, 0, 1, 2, MT, 0, 11),
    GEMMP(K_GRGIN, 1, MT, 2048, 1024, 1024, 1024, 1024, BIGG, 0, OFF_XN, OFF_RGIN, 0),
    MISCP(K_CONV),
    GEMMP(K_GGATE, 1, MT, 4096, 256, 1024, 256, 0, 4, 0, OFF_UC, OFF_GATE, 0),
    MISCP(K_S1), MISCP(K_S3),
    GEMMP(K_GSTORE, 1, MT, 1024, 1024, 1024, 1024, 1024, BIGG, 0, OFF_YG, OFF_RGOUT, OFF_Y),
    ROWP(0, 0, 1, 3, 2, 1, 0, 2, 4, MT, 1, 0),
    G1P(OFF_WIN0 + SZ_WIN, MT), G2L(OFF_H, OFF_WOUT0 + SZ_WOUT, 2816, OFF_Y), G2C(OFF_H, OFF_WOUT0 + SZ_WOUT, 2816),
    ROWP(0, 0, 2, 5, 1, 1, 1, 0, 0, MT, 0, 11),
    G1P(OFF_WIN1, MT), G2L(OFF_H, OFF_WOUT1, 2816, OFF_Y), G2C(OFF_H, OFF_WOUT1, 2816),
    ROWP(0, 1, 0, 1, 1, 1, 1, 1, 2, MT, 0, 11),
    GEMMP(K_GSTORE, 1, MT, 1024, 1024, 1024, 1024, 1024, BIGG, 0, OFF_XN, OFF_WA, OFF_CA),
    MISCP(K_MLAN),
    GEMMP(K_GQ, 0, ML, 1536, 512, 512, 512, 1536, BIGG, 0, OFF_CQ, OFF_WQB, OFF_Q),
    GEMMP(K_GSTORE, 0, MT, 1024, 256, 256, 256, 1024, BIGG, 128, OFF_CKV, OFF_WKN, OFF_KN),
    GEMMP(K_GVT, 1, 1024, MT, 256, 256, 256, 0, BIGG, 64, OFF_WV, OFF_CKV, OFF_VT),
    MISCP(K_ATT),
    GEMMP(K_GSTORE, 1, ML, 1024, 1024, 1024, 1024, 1024, BIGG, 0, OFF_O, OFF_WO, OFF_Y),
    ROWP(0, 1, 1, 3, 2, 1, 1, 2, 4, ML, 0, 0),
    G1P(OFF_WIN1 + SZ_WIN, ML), G2P(OFF_WOUT1 + SZ_WOUT, ML),
    ROWP(0, 1, 2, 5, 1, 0, 0, 0, 0, ML, 0, 0),
};

template <class Epi> DI void run_gemm(LAS unsigned char* lds, const Ctx& p, const PD& d, const Epi& E) {
    pg8::Gemm g; g.A = (const bf16_t*)(p.ws + d.offA); g.Bt = (const bf16_t*)(p.ws + d.offB); g.M = d.M; g.N = d.N; g.K = d.K; g.lda = d.lda; g.ldb = d.ldb; g.agrp = d.agrp; g.bmod = BIGG;
    pg8::StaticOrder S; S.init(d.M, d.N, (int)gridDim.x, (int)((bid_l() + (unsigned)d.rot) % gridDim.x));
    pg8::gemm_phase<Epi, pg8::StaticOrder, false>(lds, g, S, E, nullptr);
}

__global__ void __launch_bounds__(512, 2) mega_fwd(Params kp) {
    extern __shared__ __attribute__((aligned(16))) unsigned char shm[];
    cg::grid_group grid = cg::this_grid();
    LAS unsigned char* lds = (LAS unsigned char*)shm;
    volatile XLAS unsigned* xst = (volatile XLAS unsigned*)(lds + 131072);
    if (tid_l() == 0) { xst[0] = 0u; xst[1] = 0u; xst[2] = 0u; xst[3] = 0u; }
    __syncthreads();
    const XcdBarrier xb = xcd_barrier_post((unsigned*)(kp.ws + OFF_BAR), xst);
    int ph = kp.ph_lo;
#if defined(PROBE_KIND)
#ifndef PROBE_PH
#define PROBE_PH -1
#endif
    int rep_ = 0;
#endif
#if defined(PROBE_PRO)
    if (ph == 0) { prologue_phase(kp, (float*)shm); __syncthreads(); }
#endif
    if (kp.ph_hi < 0) grid.sync();
    if (ph == 0) { prologue_phase(kp, (float*)shm); ph = 1; if (ph < kp.ph_hi) xcd_barrier(xb); }
    for (; ph < kp.ph_hi; ++ph) {
        Ctx p; { unsigned long long w = (unsigned long long)kp.ws, o = (unsigned long long)kp.out; asm volatile("" : "+s"(w), "+s"(o));
            p.ws = (unsigned char*)(GAS unsigned char*)w; p.out = (float*)(GAS float*)o; p.tab = (const float* const*)(GAS const float* const*)(w + OFF_TAB); }
        const PD& d = PROG[ph];
        switch (d.kind) {
            case K_ROW: { if (d.agrp) { convert_set_b(p, (float*)shm); }
                RowD rd; rd.first = d.r[0]; rd.pl = d.r[1]; rd.psub = d.r[2]; rd.pg = d.r[3]; rd.pw2 = d.r[4]; rd.has_next = d.r[5]; rd.nl = d.r[6]; rd.nsub = d.r[7]; rd.ng = d.r[8]; rd.M = d.M; rd.nsplit = d.rot; row_phase(p, rd); } break;
            case K_GSWI: { EpiSwiglu E; E.H = (bf16_t*)(p.ws + d.offO); run_gemm(lds, p, d, E); } break;
            case K_GSTORE: { EpiStore E; E.O = (bf16_t*)(p.ws + d.offO); E.ldo = d.ldo; run_gemm(lds, p, d, E); } break;
            case K_GPART: { EpiPart E; E.P = (float*)(p.ws + OFF_PART); E.nct = d.ldo; pg8::Gemm g; g.A = (const bf16_t*)(p.ws + d.offA); g.Bt = (const bf16_t*)(p.ws + d.offB); g.M = d.M; g.N = d.N; g.K = d.K; g.lda = d.lda; g.ldb = d.ldb; g.agrp = d.ldo; g.bmod = d.ldo;
                pg8::StaticOrder S; S.init(d.M, d.N, (int)gridDim.x, (int)((bid_l() + 40u) % gridDim.x)); pg8::gemm_phase<EpiPart, pg8::StaticOrder, false>(lds, g, S, E, nullptr); } break;
            case K_GRGIN: { EpiRgIn E; E.YG = (bf16_t*)(p.ws + OFF_YG); E.U = (bf16_t*)(p.ws + OFF_U); run_gemm(lds, p, d, E); } break;
            case K_CONV: conv_phase(p); break;
            case K_GGATE: { EpiGate E; E.UC = (const bf16_t*)(p.ws + OFF_UC); E.gate_b = p.in(I_GATEB); E.lam = p.in(I_LAM); E.AB0 = (__half2*)(p.ws + OFF_AB0); E.AB1 = (__half2*)(p.ws + OFF_AB1); run_gemm(lds, p, d, E); } break;
            case K_S1: scan1_phase(p, lds); break;
            case K_S3: scan3_phase(p, lds); break;
            case K_MLAN: mla_norm_phase(p); break;
            case K_GQ: { EpiQ E; E.Q = (bf16_t*)(p.ws + OFF_Q); E.rope = (const float*)(p.ws + OFF_ROPE); run_gemm(lds, p, d, E); } break;
            case K_GVT: { EpiVT E; E.VT = (bf16_t*)(p.ws + OFF_VT); run_gemm(lds, p, d, E); } break;
            case K_ATT: attn_phase(p, lds); break;
            default: break;
        }
#if defined(PROBE_KIND)
        if ((((PROBE_KIND >> d.kind) & 1) || ph == PROBE_PH) && rep_ < PROBE_REP) { ++rep_; --ph; xcd_barrier(xb); continue; }
        rep_ = 0;
#endif
#if defined(PROBE_SYNC)
        for (int i_ = 0; i_ < PROBE_SYNC; ++i_) xcd_barrier(xb);
#endif
        if (d.sync && ph + 1 < kp.ph_hi) xcd_barrier(xb);
    }
}

extern "C" void kernel_launch(void* const* d_in, const int* in_sizes, int n_in, void* d_out, int out_size, void* d_ws, size_t ws_size, hipStream_t stream) {
    static int grid_blocks = 0;
    if (!grid_blocks) {
        int dev = 0, cus = 0, per_cu = 0;
        (void)hipGetDevice(&dev);
        (void)hipDeviceGetAttribute(&cus, hipDeviceAttributeMultiprocessorCount, dev);
        if (hipFuncSetAttribute((const void*)mega_fwd, hipFuncAttributeMaxDynamicSharedMemorySize, LDS_BYTES + 16) != hipSuccess) { fprintf(stderr, "kernel_launch: hipFuncSetAttribute failed\n"); }
        (void)hipOccupancyMaxActiveBlocksPerMultiprocessor(&per_cu, (const void*)mega_fwd, 512, LDS_BYTES + 16);
        if (per_cu < 1) { fprintf(stderr, "kernel_launch: occupancy query reports %d blocks per CU\n", per_cu); per_cu = 1; }
        grid_blocks = cus;
        (void)hipGetLastError();
    }
    if (n_in != 27 || ws_size < WS_TOTAL) { fprintf(stderr, "kernel_launch: unexpected n_in %d or workspace %zu < %zu\n", n_in, ws_size, (size_t)WS_TOTAL); return; }
    Params p{};
    for (int i = 0; i < 27; ++i) p.inp[i] = (const float*)d_in[i];
    p.out = (float*)d_out; p.ws = (unsigned char*)d_ws; p.ph_lo = 0; p.ph_hi = NPH;
    if (hipMemsetAsync((unsigned char*)d_ws + OFF_BAR, 0, XCD_BAR_WORDS * sizeof(unsigned), stream) != hipSuccess) { fprintf(stderr, "kernel_launch: memset of the barrier words failed\n"); return; }
    void* args[] = {&p};
    hipError_t e = hipLaunchCooperativeKernel((const void*)mega_fwd, dim3(grid_blocks), dim3(512), args, LDS_BYTES + 16, stream);
    if (e != hipSuccess) fprintf(stderr, "kernel_launch: cooperative launch failed: %s (grid %d)\n", hipGetErrorString(e), grid_blocks);
}
```

```cpp
#include <hip/hip_runtime.h>
#include <hip/hip_cooperative_groups.h>
#include <hip/hip_fp16.h>
#include <cstdio>
namespace cg = cooperative_groups;
__device__ __forceinline__ int tid_l() { int t = threadIdx.x; asm volatile("" : "+v"(t)); return t; }
__device__ __forceinline__ int bid_l() { int b = blockIdx.x; asm volatile("" : "+s"(b)); return b; }
#define XB_TMO      128
#define XB_XCNT(j)  (256  + 64 * (j))
#define XB_XSUB(j)  (1280 + 64 * (j))
#define XB_XGEN(j)  (2304 + 64 * (j))
#define XB_TOP      3328
#define XB_TOPGEN   3392
#define XCD_BAR_WORDS 3456
#define XB_SPIN_CAP (1u << 18)
#define XLAS __attribute__((address_space(3)))

__device__ __forceinline__ unsigned xb_ld(unsigned* p)              { return __hip_atomic_load(p, __ATOMIC_RELAXED, __HIP_MEMORY_SCOPE_AGENT); }
__device__ __forceinline__ unsigned xb_add(unsigned* p, unsigned v) { return __hip_atomic_fetch_add(p, v, __ATOMIC_RELAXED, __HIP_MEMORY_SCOPE_AGENT); }
__device__ __forceinline__ unsigned xb_xcc_id() { return (unsigned)__builtin_amdgcn_s_getreg((3 << 11) | 20) & 0xFu; }
#define XB_SPIN(cond, bar) do { unsigned _sp = 0; while (cond) { __builtin_amdgcn_s_sleep(1); \
    if ((++_sp & 255u) == 0u) { if (xb_ld(&(bar)[XB_TMO])) break; if (_sp > XB_SPIN_CAP) { atomicAdd(&(bar)[XB_TMO], 1u); break; } } } } while (0)

struct XcdBarrier {
    unsigned* bar; unsigned x;
    volatile XLAS unsigned* st;
};

__device__ __forceinline__ XcdBarrier xcd_barrier_post(unsigned* bar, volatile XLAS unsigned* st) {
    XcdBarrier b; b.bar = bar; b.x = xb_xcc_id(); b.st = st;
    if (tid_l() == 0) (void)xb_add(&bar[XB_XCNT(b.x)], 1u);
    return b;
}
__device__ __forceinline__ void xcd_barrier_complete(unsigned* bar, unsigned x, unsigned& nloc, unsigned& nx) {
    const unsigned G = gridDim.x * gridDim.y * gridDim.z;
    unsigned sum, cnt, mine, sp = 0u;
    for (;;) {
        sum = 0u; cnt = 0u; mine = 0u;
#pragma unroll
        for (unsigned j = 0; j < 16; ++j) { const unsigned c = xb_ld(&bar[XB_XCNT(j)]); sum += c; cnt += (c > 0u) ? 1u : 0u; mine = (j == x) ? c : mine; }
        if (sum == G) break;
        __builtin_amdgcn_s_sleep(1);
        if ((++sp & 255u) == 0u) { if (xb_ld(&bar[XB_TMO])) break; if (sp > XB_SPIN_CAP) { atomicAdd(&bar[XB_TMO], 1u); break; } }
    }
    nloc = mine > 0u ? mine : 1u; nx = cnt > 0u ? cnt : 1u;
}

__device__ __forceinline__ void xcd_barrier(const XcdBarrier& b) {
    asm volatile("s_waitcnt vmcnt(0)" ::: "memory");
    __syncthreads();
    if (tid_l() == 0) {
        unsigned* bar = b.bar;
        __builtin_amdgcn_s_waitcnt(0);
        unsigned nloc = b.st[0], nx = b.st[1];
        if (nloc == 0u) { xcd_barrier_complete(bar, b.x, nloc, nx); b.st[0] = nloc; b.st[1] = nx; }
        const unsigned old = xb_add(&bar[XB_XSUB(b.x)], 1u);
        const unsigned gen = old / nloc;
        if (old + 1u == (gen + 1u) * nloc) {
            __builtin_amdgcn_fence(__ATOMIC_RELEASE, "agent");
            asm volatile("s_waitcnt vmcnt(0)" ::: "memory");
            const unsigned og = xb_add(&bar[XB_TOP], 1u);
            const unsigned tg = og / nx;
            if (og + 1u == (tg + 1u) * nx) xb_add(&bar[XB_TOPGEN], 1u);
            else XB_SPIN(xb_ld(&bar[XB_TOPGEN]) == tg, bar);
            __builtin_amdgcn_fence(__ATOMIC_ACQUIRE, "agent");
            xb_add(&bar[XB_XGEN(b.x)], 1u);
            asm volatile("s_waitcnt vmcnt(0)" ::: "memory");
        } else {
            XB_SPIN(xb_ld(&bar[XB_XGEN(b.x)]) == gen, bar);
            __builtin_amdgcn_fence(__ATOMIC_ACQUIRE, "agent");
            asm volatile("s_waitcnt vmcnt(0)" ::: "memory");
        }
    }
    __syncthreads();
}

namespace pg8 {
#define PG8_LAS __attribute__((address_space(3)))
typedef unsigned short bf16_t;
typedef short bf16x8 __attribute__((ext_vector_type(8)));
typedef float f32x4 __attribute__((ext_vector_type(4)));
typedef unsigned u32x4 __attribute__((ext_vector_type(4)));
constexpr int BM = 256, BK = 64, HALF = 128, HTB = HALF * BK * 2  , STAGE_BYTES = 8 * HTB, NXCD = 8, WGM = 4;

__host__ __device__ __forceinline__ int lds_byte(int r, int c) { const int st = (r >> 4) * 2 + (c >> 5), rr = r & 15, cc = c & 31, ob = rr * 64 + cc * 2; return st * 1024 + (ob ^ (((ob >> 9) & 1) << 5)); }
__host__ __device__ __forceinline__ void stage_rc(int b, int& R, int& C) { const int st = b / 1024, sb = b % 1024, swz = sb ^ (((sb >> 9) & 1) << 5); R = (st >> 1) * 16 + swz / 64; C = (st & 1) * 32 + (swz % 64) / 2; }
__host__ __device__ __forceinline__ int perm32(int rho) { const int n = rho >> 4, i = rho & 15; return 8 * (i >> 2) + 4 * n + (i & 3); }

struct Unit { int pm, pn; };
struct Gemm { const bf16_t* A; const bf16_t* Bt; int M, N, K, lda, ldb, agrp, bmod; };

struct StaticOrder {
    int nM, nN, nwg, G, c;
    __host__ __device__ void init(int M, int N, int G_, int c_) { nM = M / BM; nN = N / BM; nwg = nM * nN; G = G_; c = c_; }
    __host__ __device__ bool next(int i, Unit& u) const {
        const long L = (long)i * G + c; if (L >= nwg) return false;
        int wgid = (int)L; { const int q = nwg / NXCD, r = nwg % NXCD, xcd = wgid % NXCD, off = wgid / NXCD; wgid = (xcd < r ? xcd * (q + 1) : r * (q + 1) + (xcd - r) * q) + off; }
        const int nig = WGM * nN, gid = wgid / nig, fm = gid * WGM, gsz = (nM - fm) < WGM ? (nM - fm) : WGM;
        u.pm = fm + ((wgid % nig) % gsz); u.pn = (wgid % nig) / gsz; return true;
    }
    __device__ __forceinline__ void a_ready(const Unit&) const {}
    __device__ __forceinline__ void done(const Unit&) const {}
};
template <class Epi, class Sched, bool STAMP = false>
__device__ __forceinline__ void gemm_phase(PG8_LAS unsigned char* lds, const Gemm g, const Sched& S, const Epi& E, unsigned long long* stamps) {
    const int tid = tid_l(), wid = __builtin_amdgcn_readfirstlane(tid >> 6), lane = tid & 63, wr = wid >> 2, wc = wid & 3, fr = lane & 15, fq = lane >> 4;
    const int K = g.K, nt = K / BK;
    unsigned voffA[2], voffB[2];
#pragma unroll
    for (int i = 0; i < 2; ++i) { int R, C; stage_rc(tid * 16 + i * 8192, R, C); const int Rb = Epi::PERM ? ((R & ~31) + perm32(R & 31)) : R;
        voffA[i] = (unsigned)(R * g.lda + C) * 2u; voffB[i] = (unsigned)(Rb * g.ldb + C) * 2u; }
    const size_t kstep = (size_t)(BK * 2);
    const size_t hstepA = (size_t)HALF * g.lda * 2, hstepB = (size_t)HALF * g.ldb * 2;
    const size_t tstepA = 2 * hstepA, tstepB = 2 * hstepB;
    const unsigned ldsw = (unsigned)wid * 1024u;
    const int aoff = lds_byte(wr * 64 + fr, fq * 8), boff = lds_byte(wc * 32 + fr, fq * 8);
#define PG8_SA(b, h) (((b) * 2 + (h)) * HTB)
#define PG8_SB(b, h) ((4 + (b) * 2 + (h)) * HTB)
#define PG8_STAGE(bufoff, gbase, voff) do { _Pragma("unroll") for (int _i = 0; _i < 2; ++_i) \
        __builtin_amdgcn_global_load_lds((const unsigned*)((const char*)(gbase) + (voff)[_i]), (PG8_LAS unsigned*)(lds + (bufoff) + ldsw + _i * 8192), 16, 0, 0); } while (0)
#define PG8_LDA(dst, b, h) do { _Pragma("unroll") for (int m = 0; m < 4; ++m) _Pragma("unroll") for (int k = 0; k < 2; ++k) dst[m][k] = *(const PG8_LAS bf16x8*)(lds + PG8_SA(b, h) + aoff + m * 2048 + k * 1024); } while (0)
#define PG8_LDB(dst, b, h) do { _Pragma("unroll") for (int n = 0; n < 2; ++n) _Pragma("unroll") for (int k = 0; k < 2; ++k) dst[n][k] = *(const PG8_LAS bf16x8*)(lds + PG8_SB(b, h) + boff + n * 2048 + k * 1024); } while (0)
#define PG8_MMA(ai, bj, At, Bt) do { __builtin_amdgcn_s_setprio(1); _Pragma("unroll") for (int m = 0; m < 4; ++m) _Pragma("unroll") for (int n = 0; n < 2; ++n) _Pragma("unroll") for (int k = 0; k < 2; ++k) \
        acc[ai][bj][m][n] = __builtin_amdgcn_mfma_f32_16x16x32_bf16(Bt[n][k], At[m][k], acc[ai][bj][m][n], 0, 0, 0); __builtin_amdgcn_s_setprio(0); } while (0)
#define PG8_WAIT_V(n) asm volatile("s_waitcnt vmcnt(" #n ")" ::: "memory")
#define PG8_WAIT_L(n) asm volatile("s_waitcnt lgkmcnt(" #n ")" ::: "memory")
#define PG8_BAR __builtin_amdgcn_s_barrier()
#define PG8_SCHED __builtin_amdgcn_sched_barrier(0)
    Unit cur, nxt; int ui = 0;
    if (!S.next(0, cur)) return;
    f32x4 acc[2][2][4][2];
#pragma unroll
    for (int a = 0; a < 2; ++a)
#pragma unroll
        for (int b = 0; b < 2; ++b)
#pragma unroll
            for (int m = 0; m < 4; ++m)
#pragma unroll
                for (int n = 0; n < 2; ++n) acc[a][b][m][n] = (f32x4){0.f, 0.f, 0.f, 0.f};
    bf16x8 At[4][2], B0[2][2], B1[2][2];
    const char* cA = (const char*)g.A + (size_t)cur.pm * tstepA + (size_t)(cur.pn / g.agrp) * K * 2; const char* cB = (const char*)g.Bt + (size_t)(cur.pn % g.bmod) * tstepB + (size_t)(cur.pn / g.bmod) * K * 2;
    S.a_ready(cur);
    PG8_STAGE(PG8_SB(0, 0), cB, voffB); PG8_STAGE(PG8_SA(0, 0), cA, voffA); PG8_STAGE(PG8_SB(0, 1), cB + hstepB, voffB); PG8_STAGE(PG8_SA(0, 1), cA + hstepA, voffA);
    if (wr == 1) PG8_BAR;
    PG8_WAIT_V(4); PG8_BAR;
    PG8_STAGE(PG8_SB(1, 0), cB + kstep, voffB); PG8_STAGE(PG8_SA(1, 0), cA + kstep, voffA); PG8_STAGE(PG8_SB(1, 1), cB + hstepB + kstep, voffB);
    PG8_WAIT_V(6); PG8_BAR;
    for (;;) {
        const bool has_next = S.next(ui + 1, nxt);
        const char* nA = has_next ? (const char*)g.A + (size_t)nxt.pm * tstepA + (size_t)(nxt.pn / g.agrp) * K * 2 : cA; const char* nB = has_next ? (const char*)g.Bt + (size_t)(nxt.pn % g.bmod) * tstepB + (size_t)(nxt.pn / g.bmod) * K * 2 : cB;
        for (int t = 0; t < nt; t += 2) {
            const bool last = (t == nt - 2);
            const char* a1 = cA + (size_t)(t + 1) * kstep;
            const char* a2 = last ? nA : cA + (size_t)(t + 2) * kstep; const char* b2 = last ? nB : cB + (size_t)(t + 2) * kstep;
            const char* a3 = a2 + kstep; const char* b3 = b2 + kstep;
            if (last && has_next) S.a_ready(nxt);
            PG8_LDB(B0, 0, 0); PG8_SCHED; PG8_LDA(At, 0, 0); PG8_STAGE(PG8_SA(1, 1), a1 + hstepA, voffA);
            PG8_WAIT_L(8); PG8_BAR; PG8_WAIT_L(0); PG8_MMA(0, 0, At, B0); PG8_BAR; PG8_SCHED;
            PG8_LDB(B1, 0, 1); PG8_STAGE(PG8_SB(0, 0), b2, voffB);
            PG8_BAR; PG8_WAIT_L(0); PG8_MMA(0, 1, At, B1); PG8_BAR;
            PG8_LDA(At, 0, 1); PG8_STAGE(PG8_SA(0, 0), a2, voffA);
            PG8_BAR; PG8_WAIT_L(0); PG8_MMA(1, 0, At, B0); PG8_BAR; PG8_SCHED;
            PG8_STAGE(PG8_SB(0, 1), b2 + hstepB, voffB);
            PG8_WAIT_V(6); PG8_BAR; PG8_MMA(1, 1, At, B1); PG8_BAR;
            PG8_LDB(B0, 1, 0); PG8_SCHED; PG8_LDA(At, 1, 0); PG8_STAGE(PG8_SA(0, 1), a2 + hstepA, voffA);
            PG8_WAIT_L(8); PG8_BAR; PG8_WAIT_L(0); PG8_MMA(0, 0, At, B0); PG8_BAR; PG8_SCHED;
            PG8_LDB(B1, 1, 1); PG8_STAGE(PG8_SB(1, 0), b3, voffB);
            PG8_BAR; PG8_WAIT_L(0); PG8_MMA(0, 1, At, B1); PG8_BAR;
            PG8_LDA(At, 1, 1); PG8_STAGE(PG8_SA(1, 0), a3, voffA);
            PG8_BAR; PG8_WAIT_L(0); PG8_MMA(1, 0, At, B0); PG8_BAR; PG8_SCHED;
            PG8_STAGE(PG8_SB(1, 1), b3 + hstepB, voffB);
            PG8_WAIT_V(6); PG8_BAR; PG8_MMA(1, 1, At, B1); PG8_BAR;
        }
        if constexpr (!Epi::AFTER_DRAIN) { E(acc, cur, wr, wc, fr, fq); S.done(cur); }
        if (!has_next) break;
#pragma unroll
        for (int a = 0; a < 2; ++a)
#pragma unroll
            for (int b = 0; b < 2; ++b)
#pragma unroll
                for (int m = 0; m < 4; ++m)
#pragma unroll
                    for (int n = 0; n < 2; ++n) acc[a][b][m][n] = (f32x4){0.f, 0.f, 0.f, 0.f};
        cur = nxt; cA = nA; cB = nB; ++ui;
    }
    PG8_WAIT_V(0);
    if (wr == 0) PG8_BAR;
    PG8_BAR;
    if constexpr (Epi::AFTER_DRAIN) { E.fused(acc, cur, wr, wc, fr, fq, lds, wid, lane); S.done(cur); }
#undef PG8_SA
#undef PG8_SB
#undef PG8_STAGE
#undef PG8_LDA
#undef PG8_LDB
#undef PG8_MMA
#undef PG8_WAIT_V
#undef PG8_WAIT_L
#undef PG8_BAR
#undef PG8_SCHED
}
}
#define DI __device__ __forceinline__
#define LAS __attribute__((address_space(3)))
#define GAS __attribute__((address_space(1)))
using pg8::bf16_t; using pg8::bf16x8; using pg8::f32x4; using pg8::u32x4; using pg8::Unit;
typedef float f32x2 __attribute__((ext_vector_type(2)));
typedef float f32x16 __attribute__((ext_vector_type(16)));
typedef unsigned u32x2 __attribute__((ext_vector_type(2)));
typedef __bf16 bf2_t __attribute__((ext_vector_type(2)));
constexpr int DM = 1024, ML = 16384, MC = 1024, MT = ML + MC, DFF = 2816, NKEY = 4352, NCH = 68  ;
constexpr size_t MiB = 1048576;
constexpr size_t OFF_MOD = 0, OFF_ROPE = MiB / 2, OFF_CAR = 256 * MiB  , OFF_XC = 6 * MiB;
constexpr size_t OFF_WIN0 = 10 * MiB, OFF_WOUT0 = 32 * MiB, OFF_RGIN = 43 * MiB, OFF_RGOUT = 47 * MiB, OFF_GATE = 49 * MiB;
constexpr size_t SZ_WIN = (size_t)5632 * 1024 * 2, SZ_WOUT = (size_t)1024 * 2816 * 2;
constexpr size_t OFF_R0 = 52 * MiB, OFF_R1 = 86 * MiB, OFF_R2 = 120 * MiB;
constexpr size_t OFF_XN = OFF_R0, OFF_UC = OFF_R0, OFF_Y = OFF_R0, OFF_VT = OFF_R0;
constexpr size_t OFF_H = OFF_R1, OFF_YG = OFF_R1, OFF_CA = OFF_R1, OFF_O = OFF_R1;
constexpr size_t OFF_U = OFF_R2, OFF_AB0 = 120 * MiB, OFF_AB1 = 188 * MiB;
constexpr size_t OFF_WIN1 = 180 * MiB, OFF_WOUT1 = 202 * MiB, OFF_WA = 213 * MiB, OFF_WQB = 215 * MiB, OFF_WKN = 216 * MiB + MiB / 2, OFF_WV = 217 * MiB, OFF_WO = 217 * MiB + MiB / 2;
constexpr size_t OFF_Q = 120 * MiB, OFF_CKV = 168 * MiB, OFF_KR = 177 * MiB, OFF_KN = 220 * MiB, OFF_CQ = 256 * MiB, WS_TOTAL = 272 * MiB;
constexpr size_t OFF_PART = 220 * MiB;
constexpr int LDS_BYTES = 131072;
constexpr float QSCALE = 0.07216878364870322f * 1.4426950408889634f;

constexpr size_t OFF_BAR = MiB / 2 + 131072;
constexpr size_t OFF_TAB = MiB / 2 + 65536;
struct Params {
    const float* inp[27]; float* out; unsigned char* ws; int ph_lo, ph_hi;
    DI const float* in(int i) const { return inp[i]; }
};
struct Ctx {
    unsigned char* ws; float* out; const float* const* tab;
    DI const float* in(int i) const { return (const float*)(GAS const float*)(unsigned long long)tab[i]; }
};
enum { I_X = 0, I_C, I_CTX, I_CCTX, I_MODW0, I_MODB0, I_NORMG0, I_FIN0, I_FOUT0, I_RGIN, I_CONVW, I_CONVB, I_GATEW, I_GATEB, I_LAM, I_RGOUT, I_MODW1, I_MODB1, I_NORMG1, I_FIN1, I_FOUT1, I_WA, I_QNORM, I_KVNORM, I_WQB, I_WKVB, I_WO };
DI unsigned pk2(float a, float b) { f32x2 v = {a, b}; return __builtin_bit_cast(unsigned, __builtin_convertvector(v, bf2_t)); }
DI float bflo(unsigned u) { return __uint_as_float(u << 16); }
DI float bfhi(unsigned u) { return __uint_as_float(u & 0xffff0000u); }
DI float bf1(bf16_t v) { return __uint_as_float(((unsigned)v) << 16); }
template <int CTRL> DI float dpp_f(float v) { return __int_as_float(__builtin_amdgcn_mov_dpp(__float_as_int(v), CTRL, 0xf, 0xf, true)); }
DI float wave_sum(float v) {
    v += dpp_f<0xB1>(v); v += dpp_f<0x4E>(v); v += dpp_f<0x141>(v); v += dpp_f<0x140>(v);
    { const auto r = __builtin_amdgcn_permlane16_swap(__float_as_uint(v), __float_as_uint(v), false, false); v = __uint_as_float(r[0]) + __uint_as_float(r[1]); }
    { const auto r = __builtin_amdgcn_permlane32_swap(__float_as_uint(v), __float_as_uint(v), false, false); v = __uint_as_float(r[0]) + __uint_as_float(r[1]); }
    return v; }
DI float sigm(float x) { return __builtin_amdgcn_rcpf(1.f + __expf(-x)); }
DI int rope_orig(int p) { const int pid = 4 * (p >> 3) + (p & 3), s = (p >> 2) & 1; return (pid >> 4) * 32 + s * 16 + (pid & 15); }

struct EpiStore {
    static constexpr bool PERM = true, AFTER_DRAIN = false;
    bf16_t* O; int ldo;
    DI void operator()(const f32x4 (&acc)[2][2][4][2], const Unit& u, int wr, int wc, int fr, int fq) const {
        const int row0 = u.pm * 256 + wr * 64 + fr, col0 = u.pn * 256 + wc * 32 + 8 * fq;
#pragma unroll
        for (int ai = 0; ai < 2; ++ai)
#pragma unroll
            for (int m = 0; m < 4; ++m) { bf16_t* rowp = O + (size_t)(row0 + ai * 128 + m * 16) * ldo + col0;
#pragma unroll
                for (int bj = 0; bj < 2; ++bj) { const f32x4 v0 = acc[ai][bj][m][0], v1 = acc[ai][bj][m][1];
                    *(u32x4*)(rowp + bj * 128) = (u32x4){pk2(v0[0], v0[1]), pk2(v0[2], v0[3]), pk2(v1[0], v1[1]), pk2(v1[2], v1[3])}; } }
    }
};
struct EpiPart {
    static constexpr bool PERM = false, AFTER_DRAIN = false;
    float* P; int nct;
    DI void operator()(const f32x4 (&acc)[2][2][4][2], const Unit& u, int wr, int wc, int fr, int fq) const {
        const int ld = nct * 256, row0 = u.pm * 256 + wr * 64 + fr, col0 = (u.pn % nct) * 256 + wc * 32 + 4 * fq; float* base = P + (size_t)(u.pn / nct) * 1024 * ld;
#pragma unroll
        for (int ai = 0; ai < 2; ++ai)
#pragma unroll
            for (int m = 0; m < 4; ++m) { float* rowp = base + (size_t)(row0 + ai * 128 + m * 16) * ld + col0;
#pragma unroll
                for (int bj = 0; bj < 2; ++bj)
#pragma unroll
                    for (int n = 0; n < 2; ++n) *(f32x4*)(rowp + bj * 128 + n * 16) = acc[ai][bj][m][n]; }
    }
};
struct EpiSwiglu {
    static constexpr bool PERM = true, AFTER_DRAIN = false;
    bf16_t* H;
    DI void operator()(const f32x4 (&acc)[2][2][4][2], const Unit& u, int wr, int wc, int fr, int fq) const {
        const int row0 = u.pm * 256 + wr * 64 + fr, col0 = u.pn * 128 + wc * 32 + 8 * fq;
#pragma unroll
        for (int ai = 0; ai < 2; ++ai)
#pragma unroll
            for (int m = 0; m < 4; ++m) { float h[8];
#pragma unroll
                for (int n = 0; n < 2; ++n)
#pragma unroll
                    for (int i = 0; i < 4; ++i) { const float a = acc[ai][0][m][n][i], b = acc[ai][1][m][n][i]; h[n * 4 + i] = a * sigm(a) * b; }
                *(u32x4*)(H + (size_t)(row0 + ai * 128 + m * 16) * DFF + col0) = (u32x4){pk2(h[0], h[1]), pk2(h[2], h[3]), pk2(h[4], h[5]), pk2(h[6], h[7])}; }
    }
};
DI float gelu_tanh(float x) { const float z = 0.7978845608028654f * (x + 0.044715f * x * x * x); return x * sigm(2.f * z); }
struct EpiRgIn {
    static constexpr bool PERM = true, AFTER_DRAIN = false;
    bf16_t* YG; bf16_t* U;
    DI void operator()(const f32x4 (&acc)[2][2][4][2], const Unit& u, int wr, int wc, int fr, int fq) const {
        const int row0 = u.pm * 256 + wr * 64 + fr, col0 = (u.pn & 3) * 256 + wc * 32 + 8 * fq; const bool isy = u.pn < 4; bf16_t* dst = isy ? YG : U;
#pragma unroll
        for (int ai = 0; ai < 2; ++ai)
#pragma unroll
            for (int m = 0; m < 4; ++m) { bf16_t* rowp = dst + (size_t)(row0 + ai * 128 + m * 16) * DM + col0;
#pragma unroll
                for (int bj = 0; bj < 2; ++bj) { f32x4 v0 = acc[ai][bj][m][0], v1 = acc[ai][bj][m][1];
                    if (isy) {
#pragma unroll
                        for (int i = 0; i < 4; ++i) { v0[i] = gelu_tanh(v0[i]); v1[i] = gelu_tanh(v1[i]); } }
                    *(u32x4*)(rowp + bj * 128) = (u32x4){pk2(v0[0], v0[1]), pk2(v0[2], v0[3]), pk2(v1[0], v1[1]), pk2(v1[2], v1[3])}; } }
    }
};
DI float neg_expm1(float x) {
    const float pl = -x * (1.f + x * 0.5f * (1.f + x * (1.f / 3.f) * (1.f + x * 0.25f * (1.f + x * 0.2f * (1.f + x * (1.f / 6.f))))));
    const float ex = 1.f - __builtin_amdgcn_exp2f(x * 1.4426950408889634f);
    return x < -0.25f ? ex : pl; }
DI float log1p_small(float e) {
    const float pl = e * (1.f - e * (0.5f - e * ((1.f / 3.f) - e * (0.25f - e * 0.2f))));
    return e > 0.03f ? __logf(1.f + e) : pl; }
struct EpiGate {
    static constexpr bool PERM = false, AFTER_DRAIN = false;
    const bf16_t* UC; const float* gate_b; const float* lam; __half2* AB0; __half2* AB1;
    DI void operator()(const f32x4 (&acc)[2][2][4][2], const Unit& u, int wr, int wc, int fr, int fq) const {
        const int j2 = u.pn >> 2, d = (u.pn >> 1) & 1, half = u.pn & 1;
        const int row0 = u.pm * 256 + wr * 64 + fr, ch0 = j2 * 256 + half * 128 + wc * 32 + 4 * fq;
        __half2* AB = d ? AB1 : AB0;
        u32x2 ucv[2][2][4];
#pragma unroll
        for (int n = 0; n < 2; ++n)
#pragma unroll
            for (int ai = 0; ai < 2; ++ai)
#pragma unroll
                for (int m = 0; m < 4; ++m) ucv[n][ai][m] = *(const u32x2*)(UC + (size_t)(row0 + ai * 128 + m * 16) * DM + ch0 + 16 * n);
#pragma unroll
        for (int n = 0; n < 2; ++n) { const int ch = ch0 + 16 * n;
            const f32x4 gr = *(const f32x4*)(gate_b + (d * 2 + 0) * DM + ch), gi = *(const f32x4*)(gate_b + (d * 2 + 1) * DM + ch), l = *(const f32x4*)(lam + d * DM + ch);
            f32x4 c8;
#pragma unroll
            for (int i = 0; i < 4; ++i) c8[i] = -8.f * log1p_small(__expf(-l[i]));
#pragma unroll
            for (int ai = 0; ai < 2; ++ai)
#pragma unroll
                for (int m = 0; m < 4; ++m) { const size_t rowoff = (size_t)(row0 + ai * 128 + m * 16) * DM;
                    const u32x2 uu = ucv[n][ai][m]; const float uv[4] = {bflo(uu[0]), bfhi(uu[0]), bflo(uu[1]), bfhi(uu[1])};
                    unsigned o[4];
#pragma unroll
                    for (int i = 0; i < 4; ++i) { const float rr = sigm(acc[ai][0][m][n][i] + gr[i]), ii = sigm(acc[ai][1][m][n][i] + gi[i]);
                        const float la = c8[i] * rr; const float bv = __builtin_amdgcn_sqrtf(neg_expm1(2.f * la)) * ii * uv[i]; o[i] = __builtin_bit_cast(unsigned, __floats2half2_rn(la, bv)); }
                    *(u32x4*)(AB + rowoff + ch) = (u32x4){o[0], o[1], o[2], o[3]}; } }
    }
};
struct EpiQ {
    static constexpr bool PERM = true, AFTER_DRAIN = false;
    bf16_t* Q; const float* rope;
    DI void operator()(const f32x4 (&acc)[2][2][4][2], const Unit& u, int wr, int wc, int fr, int fq) const {
        const int row0 = u.pm * 256 + wr * 64 + fr;
#pragma unroll
        for (int bj = 0; bj < 2; ++bj) { const int c0 = u.pn * 256 + bj * 128 + wc * 32 + 8 * fq; const int h = c0 / 192, d0 = c0 - h * 192;
            const bool isrope = d0 >= 128; const int g = (d0 - 128) >> 3;
#pragma unroll
            for (int ai = 0; ai < 2; ++ai)
#pragma unroll
                for (int mp = 0; mp < 2; ++mp) {
                    f32x4 e0[2], e1[2];
#pragma unroll
                    for (int mm = 0; mm < 2; ++mm) { e0[mm] = (f32x4){1.f, 0.f, 1.f, 0.f}; e1[mm] = e0[mm]; }
                    if (isrope) {
#pragma unroll
                        for (int mm = 0; mm < 2; ++mm) { const int row = row0 + ai * 128 + (2 * mp + mm) * 16, t = row & 4095, pos = (g >> 2) ? (t & 63) : (t >> 6);
                            e0[mm] = *(const f32x4*)(rope + (pos * 16 + 4 * (g & 3)) * 2); e1[mm] = *(const f32x4*)(rope + (pos * 16 + 4 * (g & 3)) * 2 + 4); } }
#pragma unroll
                    for (int mm = 0; mm < 2; ++mm) { const int m = 2 * mp + mm, row = row0 + ai * 128 + m * 16; f32x4 v0 = acc[ai][bj][m][0], v1 = acc[ai][bj][m][1];
                        const float cc[4] = {e0[mm][0], e0[mm][2], e1[mm][0], e1[mm][2]}, sn[4] = {e0[mm][1], e0[mm][3], e1[mm][1], e1[mm][3]};
#pragma unroll
                        for (int i = 0; i < 4; ++i) { const float a_ = v0[i], b_ = v1[i]; v0[i] = a_ * cc[i] - b_ * sn[i]; v1[i] = a_ * sn[i] + b_ * cc[i]; }
                        v0 *= QSCALE; v1 *= QSCALE;
                        *(u32x4*)(Q + (size_t)row * 1536 + c0) = (u32x4){pk2(v0[0], v0[1]), pk2(v0[2], v0[3]), pk2(v1[0], v1[1]), pk2(v1[2], v1[3])}; } } }
    }
};
struct EpiVT {
    static constexpr bool PERM = false, AFTER_DRAIN = false;
    bf16_t* VT;
    DI void operator()(const f32x4 (&acc)[2][2][4][2], const Unit& u, int wr, int wc, int fr, int fq) const {
        const int f0 = u.pm * 256 + wr * 64 + fr;
#pragma unroll
        for (int bj = 0; bj < 2; ++bj)
#pragma unroll
            for (int n = 0; n < 2; ++n) { const int tok = u.pn * 256 + bj * 128 + wc * 32 + 16 * n + 4 * fq;
                int b, key; if (tok < ML) { b = tok >> 12; key = 256 + (tok & 4095); } else { b = (tok - ML) >> 8; key = (tok - ML) & 255; }
                const int qi = (key >> 2) & 3, pos = (key & ~15) + 4 * (((qi & 1) << 1) | (qi >> 1));
#pragma unroll
                for (int ai = 0; ai < 2; ++ai)
#pragma unroll
                    for (int m = 0; m < 4; ++m) { const int f = f0 + ai * 128 + m * 16; const f32x4 v = acc[ai][bj][m][n];
                        *(u32x2*)(VT + ((size_t)(b * 1024 + f)) * NKEY + pos) = (u32x2){pk2(v[0], v[1]), pk2(v[2], v[3])}; } }
    }
};
struct WD { const float* src; bf16_t* dst; int Np, K, kind, lds, nvalid; };
template <int KIND> DI float wfetch(const WD& w, int n, int k) {
    if constexpr (KIND == 6) { const int pn = n >> 8, bj = (n >> 7) & 1, jj = n & 127, j2 = pn >> 2, d = (pn >> 1) & 1, half = pn & 1;
        const float v = w.src[((((d * 2 + bj) * 8 + (2 * j2 + half)) * 128 + (k & 127)) * 128) + jj];
        return (k >> 7) != half ? 0.f : v; }
    else {
        int col; bool valid = true;
        if constexpr (KIND == 0) { valid = n < w.nvalid; col = valid ? n : 0; }
        else if constexpr (KIND == 1) col = ((n >> 7) & 1) * DFF + (n >> 8) * 128 + (n & 127);
        else if constexpr (KIND == 3) { const int h = n / 192, d = n - h * 192; col = d < 128 ? n : h * 192 + 128 + rope_orig(d < 128 ? 0 : d - 128); }
        else if constexpr (KIND == 4) col = (n >> 7) * 256 + (n & 127);
        else col = (n >> 7) * 256 + 128 + (n & 127);
        const float v = w.src[(size_t)k * w.lds + col];
        return valid ? v : 0.f; }
}
template <int KIND> DI void convert_weight(const WD& w, float* tile  ) {
    const int tid = tid_l(), lane = tid & 63, wv = tid >> 6;
    const int tk = w.K >> 6, ntile = (w.Np >> 6) * tk;
    for (int t = bid_l(); t < ntile; t += gridDim.x) {
        const int n0 = (t / tk) << 6, k0 = (t % tk) << 6;
#pragma unroll
        for (int i = 0; i < 8; ++i) { const int kl = i * 8 + wv; tile[kl * 65 + lane] = wfetch<KIND>(w, n0 + lane, k0 + kl); }
        __syncthreads();
        { const int nl = tid >> 3, kc = tid & 7; float v[8];
#pragma unroll
          for (int j = 0; j < 8; ++j) v[j] = tile[(kc * 8 + j) * 65 + nl];
          *(u32x4*)(w.dst + (size_t)(n0 + nl) * w.K + k0 + kc * 8) = (u32x4){pk2(v[0], v[1]), pk2(v[2], v[3]), pk2(v[4], v[5]), pk2(v[6], v[7])}; }
        __syncthreads();
    }
}
DI WD mkwd(const float* src, unsigned char* ws, size_t off, int Np, int K, int kind, int lds, int nvalid) { WD w; w.src = src; w.dst = (bf16_t*)(ws + off); w.Np = Np; w.K = K; w.kind = kind; w.lds = lds; w.nvalid = nvalid; return w; }
template <class P> DI void convert_set_a(const P& p, float* tile) {
    for (int s = 0; s < 2; ++s) {
        convert_weight<1>(mkwd(p.in(I_FIN0) + (size_t)s * 1024 * 5632, p.ws, OFF_WIN0 + s * SZ_WIN, 5632, 1024, 1, 5632, 5632), tile);
        convert_weight<0>(mkwd(p.in(I_FOUT0) + (size_t)s * DFF * 1024, p.ws, OFF_WOUT0 + s * SZ_WOUT, 1024, DFF, 0, 1024, 1024), tile); }
    convert_weight<0>(mkwd(p.in(I_RGIN), p.ws, OFF_RGIN, 2048, 1024, 0, 2048, 2048), tile);
    convert_weight<0>(mkwd(p.in(I_RGOUT), p.ws, OFF_RGOUT, 1024, 1024, 0, 1024, 1024), tile);
    convert_weight<6>(mkwd(p.in(I_GATEW), p.ws, OFF_GATE, 4096, 256, 6, 0, 0), tile);
}
template <class P> DI void convert_set_b(const P& p, float* tile) {
    for (int s = 0; s < 2; ++s) {
        convert_weight<1>(mkwd(p.in(I_FIN1) + (size_t)s * 1024 * 5632, p.ws, OFF_WIN1 + s * SZ_WIN, 5632, 1024, 1, 5632, 5632), tile);
        convert_weight<0>(mkwd(p.in(I_FOUT1) + (size_t)s * DFF * 1024, p.ws, OFF_WOUT1 + s * SZ_WOUT, 1024, DFF, 0, 1024, 1024), tile); }
    convert_weight<0>(mkwd(p.in(I_WA), p.ws, OFF_WA, 1024, 1024, 0, 832, 832), tile);
    convert_weight<3>(mkwd(p.in(I_WQB), p.ws, OFF_WQB, 1536, 512, 3, 1536, 1536), tile);
    convert_weight<4>(mkwd(p.in(I_WKVB), p.ws, OFF_WKN, 1024, 256, 4, 2048, 2048), tile);
    convert_weight<5>(mkwd(p.in(I_WKVB), p.ws, OFF_WV, 1024, 256, 5, 2048, 2048), tile);
    convert_weight<0>(mkwd(p.in(I_WO), p.ws, OFF_WO, 1024, 1024, 0, 1024, 1024), tile);
}
DI void prologue_phase(const Params& p, float* lds) {
    const int tid = tid_l(), lane = tid & 63, wv = tid >> 6;
    float* sv = lds;
    float* red = lds + 5 * 1024;
    float* tile = red + 8 * 5 * 64;
    for (int i = tid; i < 5 * 1024; i += 512) { const float v = i < 4096 ? p.in(I_C)[i] : p.in(I_CCTX)[i - 4096]; sv[i] = v * sigm(v); }
    __syncthreads();
    float* MOD = (float*)(p.ws + OFF_MOD);
    for (int it = bid_l(); it < 288; it += gridDim.x) {
        const int layer = it / 144, col = (it % 144) * 64 + lane; const float* W = layer ? p.in(I_MODW1) : p.in(I_MODW0); const float* MB = layer ? p.in(I_MODB1) : p.in(I_MODB0);
        float a0 = 0.f, a1 = 0.f, a2 = 0.f, a3 = 0.f, a4 = 0.f;
#pragma unroll 32
        for (int kk = 0; kk < 128; ++kk) { const int k = wv * 128 + kk; const float w = W[(size_t)k * 9216 + col];
            a0 += sv[k] * w; a1 += sv[1024 + k] * w; a2 += sv[2048 + k] * w; a3 += sv[3072 + k] * w; a4 += sv[4096 + k] * w; }
        red[(wv * 5 + 0) * 64 + lane] = a0; red[(wv * 5 + 1) * 64 + lane] = a1; red[(wv * 5 + 2) * 64 + lane] = a2; red[(wv * 5 + 3) * 64 + lane] = a3; red[(wv * 5 + 4) * 64 + lane] = a4;
        __syncthreads();
        if (tid < 320) { const int v = tid >> 6; float s = 0.f;
#pragma unroll
            for (int w8 = 0; w8 < 8; ++w8) s += red[(w8 * 5 + v) * 64 + lane];
            MOD[(size_t)(layer * 5 + v) * 9216 + col] = s + MB[col]; }
        __syncthreads();
    }
    if (bid_l() == gridDim.x - 1 && tid < 16) {
        double th = 1.0; for (int i = 0; i < tid; ++i) th *= 0.56234132519034908;
        double c1 = 1.0, s1 = th, tc = 1.0, ts = th; const double t2 = th * th;
        for (int n = 1; n <= 12; ++n) { tc *= -t2 / (double)((2 * n - 1) * (2 * n)); ts *= -t2 / (double)((2 * n) * (2 * n + 1)); c1 += tc; s1 += ts; }
        double cc = 1.0, ss = 0.0; float* RT = (float*)(p.ws + OFF_ROPE);
        for (int pos = 0; pos < 64; ++pos) { RT[(pos * 16 + tid) * 2] = (float)cc; RT[(pos * 16 + tid) * 2 + 1] = (float)ss; const double nc = cc * c1 - ss * s1, ns = cc * s1 + ss * c1; cc = nc; ss = ns; }
    }
    if (tid < 27) ((const float**)(p.ws + OFF_TAB))[tid] = p.in(tid);
    convert_set_a(p, tile);
}

struct RowD { int first, pl, psub, pg, pw2, has_next, nl, nsub, ng, M, nsplit; };
template <bool FIRST, bool HASNEXT> DI void row_phase_t(const Ctx& p, const RowD d) {
    const int tid = tid_l(), lane = tid & 63, wv = tid >> 6;
    const float* MOD = (const float*)(p.ws + OFF_MOD); float* XC = (float*)(p.ws + OFF_XC);
    bf16_t* Y = (bf16_t*)(p.ws + OFF_Y);
    const float pw = 0.5f * (float)d.pw2;
    const float* gpost = (d.pl ? p.in(I_NORMG1) : p.in(I_NORMG0)) + d.pg * DM; const float* gpre = (d.nl ? p.in(I_NORMG1) : p.in(I_NORMG0)) + d.ng * DM;
    int mb_have = -1; f32x4 cpost[4], cpre[4], shf[4];
#pragma unroll
    for (int j = 0; j < 4; ++j) { cpost[j] = (f32x4){0.f, 0.f, 0.f, 0.f}; cpre[j] = cpost[j]; shf[j] = cpost[j]; }
    const int nw = (int)gridDim.x * 8, gw = bid_l() * 8 + wv;
    const int lo = (gw * ML) / nw, hi = ((gw + 1) * ML) / nw, nlat = hi - lo;
    const int nctx = d.M > ML ? (d.M - ML - gw + nw - 1) / nw : 0;
    const int ntot = nlat + (nctx > 0 ? nctx : 0);
    for (int it = 0; it < ntot; ++it) {
        const int r = it < nlat ? lo + it : ML + gw + (it - nlat) * nw;
        const int mb = r < ML ? (r >> 12) : 4;
        float* xs = r < ML ? p.out + (size_t)r * DM : XC + (size_t)(r - ML) * DM;
        const float* xin = FIRST ? (r < ML ? p.in(I_X) + (size_t)r * DM : p.in(I_CTX) + (size_t)(r - ML) * DM) : xs;
        f32x4 xv[4]; u32x2 yv[4];
#pragma unroll
        for (int j = 0; j < 4; ++j) { xv[j] = *(const f32x4*)(xin + 256 * j + 4 * lane); yv[j] = (u32x2){0u, 0u}; }
        const bool ypart = r >= ML && d.nsplit > 0;
        if (!FIRST && !ypart) {
#pragma unroll
            for (int j = 0; j < 4; ++j) yv[j] = *(const u32x2*)(Y + (size_t)r * DM + 256 * j + 4 * lane); }
        if (mb != mb_have) { mb_have = mb;
            const float* gt = MOD + (size_t)(d.pl * 5 + mb) * 9216 + d.psub * 3072 + 2048; const float* sh = MOD + (size_t)(d.nl * 5 + mb) * 9216 + d.nsub * 3072; const float* sc = sh + 1024;
            { f32x4 a0[4], a1[4];
#pragma unroll
              for (int j = 0; j < 4; ++j) { const int c = 256 * j + 4 * lane; a0[j] = *(const f32x4*)(gpost + c); a1[j] = *(const f32x4*)(gt + c); }
#pragma unroll
              for (int j = 0; j < 4; ++j) cpost[j] = a0[j] * a1[j] * pw; }
            { f32x4 a2[4], a3[4];
#pragma unroll
              for (int j = 0; j < 4; ++j) { const int c = 256 * j + 4 * lane; a2[j] = *(const f32x4*)(gpre + c); a3[j] = *(const f32x4*)(sc + c); shf[j] = *(const f32x4*)(sh + c); }
#pragma unroll
              for (int j = 0; j < 4; ++j) cpre[j] = a2[j] * (1.f + a3[j]); } }
        if (!FIRST) {
            f32x4 yf[4]; float ss = 0.f;
            if (ypart) {
                const float* P = (const float*)(p.ws + OFF_PART) + (size_t)(r - ML) * 1024;
#pragma unroll
                for (int j = 0; j < 4; ++j) { f32x4 a;
                    if (d.nsplit == 11) { f32x4 pv[11];
#pragma unroll
                        for (int s = 0; s < 11; ++s) pv[s] = *(const f32x4*)(P + (size_t)s * 1024 * 1024 + 256 * j + 4 * lane);
                        a = pv[0];
#pragma unroll
                        for (int s = 1; s < 11; ++s) a += pv[s]; }
                    else { a = *(const f32x4*)(P + 256 * j + 4 * lane);
                        for (int s = 1; s < d.nsplit; ++s) a += *(const f32x4*)(P + (size_t)s * 1024 * 1024 + 256 * j + 4 * lane); }
                    yf[j] = a; }
            } else {
#pragma unroll
                for (int j = 0; j < 4; ++j) yf[j] = (f32x4){bflo(yv[j][0]), bfhi(yv[j][0]), bflo(yv[j][1]), bfhi(yv[j][1])};
            }
#pragma unroll
            for (int j = 0; j < 4; ++j) ss += yf[j][0] * yf[j][0] + yf[j][1] * yf[j][1] + yf[j][2] * yf[j][2] + yf[j][3] * yf[j][3];
            ss = wave_sum(ss); const float rstd = rsqrtf(ss * (1.f / 1024.f) + 1e-6f);
#pragma unroll
            for (int j = 0; j < 4; ++j) xv[j] += cpost[j] * rstd * yf[j];
        }
#pragma unroll
        for (int j = 0; j < 4; ++j) *(f32x4*)(xs + 256 * j + 4 * lane) = xv[j];
        if (HASNEXT) {
            float ss = 0.f;
#pragma unroll
            for (int j = 0; j < 4; ++j) ss += xv[j][0] * xv[j][0] + xv[j][1] * xv[j][1] + xv[j][2] * xv[j][2] + xv[j][3] * xv[j][3];
            ss = wave_sum(ss); const float rstd = rsqrtf(ss * (1.f / 1024.f) + 1e-6f);
            bf16_t* xn = (bf16_t*)(p.ws + OFF_XN) + (size_t)r * DM;
#pragma unroll
            for (int j = 0; j < 4; ++j) { const f32x4 o = xv[j] * rstd * cpre[j] + shf[j];
                *(u32x2*)(xn + 256 * j + 4 * lane) = (u32x2){pk2(o[0], o[1]), pk2(o[2], o[3])}; }
        }
    }
}

DI void row_phase(const Ctx& p, const RowD d) {
    if (d.first) row_phase_t<true, true>(p, d);
    else if (d.has_next) row_phase_t<false, true>(p, d);
    else row_phase_t<false, false>(p, d);
}

DI void conv_phase(const Ctx& p) {
    const bf16_t* U = (const bf16_t*)(p.ws + OFF_U); bf16_t* UC = (bf16_t*)(p.ws + OFF_UC); const float* cb_ = p.in(I_CONVB); const float* cw_ = p.in(I_CONVW);
    const int idx0 = bid_l() * 512 + tid_l(), c8 = (idx0 & 127) * 8;
    float w[4][8], bb[8];
    { const f32x4 b0 = *(const f32x4*)(cb_ + c8), b1 = *(const f32x4*)(cb_ + c8 + 4); bb[0] = b0[0]; bb[1] = b0[1]; bb[2] = b0[2]; bb[3] = b0[3]; bb[4] = b1[0]; bb[5] = b1[1]; bb[6] = b1[2]; bb[7] = b1[3]; }
#pragma unroll
    for (int k = 0; k < 4; ++k) { const f32x4 w0 = *(const f32x4*)(cw_ + k * DM + c8), w1 = *(const f32x4*)(cw_ + k * DM + c8 + 4);
        w[k][0] = w0[0]; w[k][1] = w0[1]; w[k][2] = w0[2]; w[k][3] = w0[3]; w[k][4] = w1[0]; w[k][5] = w1[1]; w[k][6] = w1[2]; w[k][7] = w1[3]; }
    const int step = gridDim.x * 512;
    for (int item = idx0; item < (MT / 8) * 128; item += step) {
        const int r0 = (item >> 7) * 8;
        int t0, Ls; if (r0 < ML) { t0 = r0 & 4095; Ls = 4096; } else { t0 = (r0 - ML) & 255; Ls = 256; }
        u32x4 uu[11];
#pragma unroll
        for (int i = 0; i < 11; ++i) { const int tt = t0 + i - 2; uu[i] = (u32x4){0u, 0u, 0u, 0u}; if (tt >= 0 && tt < Ls) uu[i] = *(const u32x4*)(U + (size_t)(r0 + i - 2) * DM + c8); }
#pragma unroll
        for (int q = 0; q < 8; ++q) { float a[8];
#pragma unroll
            for (int e = 0; e < 8; ++e) a[e] = bb[e];
#pragma unroll
            for (int k = 0; k < 4; ++k) { const u32x4 x = uu[q + k];
                a[0] += bflo(x[0]) * w[k][0]; a[1] += bfhi(x[0]) * w[k][1]; a[2] += bflo(x[1]) * w[k][2]; a[3] += bfhi(x[1]) * w[k][3];
                a[4] += bflo(x[2]) * w[k][4]; a[5] += bfhi(x[2]) * w[k][5]; a[6] += bflo(x[3]) * w[k][6]; a[7] += bfhi(x[3]) * w[k][7]; }
            *(u32x4*)(UC + (size_t)(r0 + q) * DM + c8) = (u32x4){pk2(a[0], a[1]), pk2(a[2], a[3]), pk2(a[4], a[5]), pk2(a[6], a[7])}; }
    }
}
constexpr int CHK = 32, NCK = 136, NSCAN_ITEMS = 4 * NCK * 4;
DI int chunk_row(int b, int k) { return k < 8 ? ML + b * 256 + CHK * k : b * 4096 + CHK * (k - 8); }
#define SCAN_LOAD(it) do { const int cg_ = (it) & 3, bk_ = (it) >> 2, b_ = bk_ / NCK, k_ = bk_ - b_ * NCK; const size_t ro_ = ((size_t)chunk_row(b_, k_) * DM + cg_ * 256) * 4; \
        const unsigned char* A0_ = p.ws + OFF_AB0 + ro_; const unsigned char* A1_ = p.ws + OFF_AB1 + ro_; \
        _Pragma("unroll") for (int i = 0; i < 4; ++i) { const int idx = tid + 512 * i, row = idx >> 6, c16 = idx & 63; \
            ta[i] = *(const u32x4*)(A0_ + (size_t)row * 4096 + c16 * 16); tb[i] = *(const u32x4*)(A1_ + (size_t)row * 4096 + c16 * 16); } } while (0)
#define SCAN_WRITE() do { _Pragma("unroll") for (int i = 0; i < 4; ++i) { const int idx = tid + 512 * i, row = idx >> 6, c16 = idx & 63; \
            *(LAS u32x4*)(lds + row * 1024 + c16 * 16) = ta[i]; *(LAS u32x4*)(lds + 32768 + row * 1024 + c16 * 16) = tb[i]; } } while (0)
DI void scan1_phase(const Ctx& p, LAS unsigned char* lds) {
    const int tid = tid_l(); f32x2* CAR = (f32x2*)(p.ws + OFF_CAR);
    u32x4 ta[4], tb[4];
    int item = bid_l();
    if (item < NSCAN_ITEMS) SCAN_LOAD(item);
    while (item < NSCAN_ITEMS) {
        const int cg = item & 3, bk = item >> 2, b = bk / NCK, k = bk - b * NCK;
        SCAN_WRITE();
        __syncthreads();
        const int nxt = item + (int)gridDim.x;
        if (nxt < NSCAN_ITEMS) SCAN_LOAD(nxt);
        { const int dir = tid >> 8, c = tid & 255; const LAS unsigned char* tl = lds + dir * 32768 + c * 4; float P = 0.f, h = 0.f;
#pragma unroll
          for (int s = 0; s < CHK; ++s) { const int t = dir ? CHK - 1 - s : s; const float2 v = __half22float2(__builtin_bit_cast(__half2, *(const LAS unsigned*)(tl + t * 1024))); P += v.x; h = __expf(v.x) * h + v.y; }
          CAR[(size_t)((dir * 4 + b) * NCK + k) * 1024 + cg * 256 + c] = (f32x2){P, h}; }
        __syncthreads();
        item = nxt;
    }
}
DI void scan3_phase(const Ctx& p, LAS unsigned char* lds) {
    const int tid = tid_l(); const f32x2* CAR = (const f32x2*)(p.ws + OFF_CAR);
    bf16_t* YG = (bf16_t*)(p.ws + OFF_YG);
    u32x4 ta[4], tb[4], ty[2];
#define SCAN_LOADY(it) do { const int cg_ = (it) & 3, bk_ = (it) >> 2, b_ = bk_ / NCK, k_ = bk_ - b_ * NCK, r0_ = chunk_row(b_, k_); \
        _Pragma("unroll") for (int i = 0; i < 2; ++i) { const int idx = tid + 512 * i, row = idx >> 5, c16 = idx & 31; ty[i] = *(const u32x4*)(YG + (size_t)(r0_ + row) * DM + cg_ * 256 + c16 * 8); } } while (0)
    int item = bid_l();
    if (item < NSCAN_ITEMS) { SCAN_LOAD(item); SCAN_LOADY(item); }
    while (item < NSCAN_ITEMS) {
        const int cg = item & 3, bk = item >> 2, b = bk / NCK, k = bk - b * NCK, row0 = chunk_row(b, k);
        SCAN_WRITE();
#pragma unroll
        for (int i = 0; i < 2; ++i) { const int idx = tid + 512 * i, row = idx >> 5, c16 = idx & 31; *(LAS u32x4*)(lds + 65536 + row * 512 + c16 * 16) = ty[i]; }
        const int dir = tid >> 8, c = tid & 255; float h = 0.f;
        { const f32x2* C = CAR + (size_t)((dir * 4 + b) * NCK) * 1024 + cg * 256 + c;
          const int npre = dir == 0 ? k : (k < 8 ? 7 - k : NCK + 7 - k);
          for (int q0 = 0; q0 < npre; q0 += 16) { f32x2 cv[16];
#pragma unroll
              for (int j = 0; j < 16; ++j) { const int q = q0 + j, kk = dir == 0 ? q : (q < 8 ? 7 - q : NCK + 7 - q); cv[j] = q < npre ? C[(size_t)kk * 1024] : (f32x2){0.f, 0.f}; }
#pragma unroll
              for (int j = 0; j < 16; ++j) h = __expf(cv[j][0]) * h + cv[j][1]; } }
        __syncthreads();
        const int nxt = item + (int)gridDim.x;
        if (nxt < NSCAN_ITEMS) { SCAN_LOAD(nxt); SCAN_LOADY(nxt); }
        { LAS unsigned char* tl = lds + dir * 32768 + c * 4;
#pragma unroll
          for (int s = 0; s < CHK; ++s) { const int t = dir ? CHK - 1 - s : s; const float2 v = __half22float2(__builtin_bit_cast(__half2, *(const LAS unsigned*)(tl + t * 1024))); h = __expf(v.x) * h + v.y; *(LAS float*)(tl + t * 1024) = h; } }
        __syncthreads();
#pragma unroll
        for (int i = 0; i < 8; ++i) { const int idx = tid + 512 * i, row = idx >> 7, cp = idx & 127;
            const f32x2 hf = *(const LAS f32x2*)(lds + row * 1024 + cp * 8), hr = *(const LAS f32x2*)(lds + 32768 + row * 1024 + cp * 8); const unsigned yg = *(const LAS unsigned*)(lds + 65536 + row * 512 + cp * 4);
            *(unsigned*)(YG + (size_t)(row0 + row) * DM + cg * 256 + cp * 2) = pk2((hf[0] + hr[0]) * bflo(yg), (hf[1] + hr[1]) * bfhi(yg)); }
        __syncthreads();
        item = nxt;
    }
#undef SCAN_LOADY
}
#undef SCAN_LOAD
#undef SCAN_WRITE

DI void mla_norm_phase(const Ctx& p) {
    const int tid = tid_l(), lane = tid & 63, wv = tid >> 6;
    const bf16_t* CA = (const bf16_t*)(p.ws + OFF_CA); bf16_t* CQ = (bf16_t*)(p.ws + OFF_CQ); bf16_t* CKV = (bf16_t*)(p.ws + OFF_CKV); bf16_t* KR = (bf16_t*)(p.ws + OFF_KR);
    const float* RT = (const float*)(p.ws + OFF_ROPE);
    const f32x4 gkv = *(const f32x4*)(p.in(I_KVNORM) + 4 * lane), gq0 = *(const f32x4*)(p.in(I_QNORM) + 8 * lane), gq1 = *(const f32x4*)(p.in(I_QNORM) + 8 * lane + 4);
    const int o = rope_orig(lane);
    const int nw = (int)gridDim.x * 8, gw = bid_l() * 8 + wv;
    for (int r = (gw * ML) / nw; r < ((gw + 1) * ML) / nw; ++r) {
        const bf16_t* row = CA + (size_t)r * DM;
        const u32x2 kv = *(const u32x2*)(row + 512 + 4 * lane); const bf16_t vraw = row[768 + o];
        const u32x4 qv = *(const u32x4*)(row + 8 * lane); const bf16_t vpraw = row[768 + (o ^ 16)];
        const int t = r & 4095, pos = (o < 32) ? (t >> 6) : (t & 63); const f32x2 csn = *(const f32x2*)(RT + (pos * 16 + (o & 15)) * 2);
        const float k0 = bflo(kv[0]), k1 = bfhi(kv[0]), k2 = bflo(kv[1]), k3 = bfhi(kv[1]);
        float q[8] = {bflo(qv[0]), bfhi(qv[0]), bflo(qv[1]), bfhi(qv[1]), bflo(qv[2]), bfhi(qv[2]), bflo(qv[3]), bfhi(qv[3])};
        float ssq = 0.f;
#pragma unroll
        for (int i = 0; i < 8; ++i) ssq += q[i] * q[i];
        const float sskv = wave_sum(k0 * k0 + k1 * k1 + k2 * k2 + k3 * k3); ssq = wave_sum(ssq);
        const float rkv = rsqrtf(sskv * (1.f / 256.f) + 1e-6f), rq = rsqrtf(ssq * (1.f / 512.f) + 1e-6f);
        *(u32x2*)(CKV + (size_t)r * 256 + 4 * lane) = (u32x2){pk2(k0 * rkv * gkv[0], k1 * rkv * gkv[1]), pk2(k2 * rkv * gkv[2], k3 * rkv * gkv[3])};
        *(u32x4*)(CQ + (size_t)r * 512 + 8 * lane) = (u32x4){pk2(q[0] * rq * gq0[0], q[1] * rq * gq0[1]), pk2(q[2] * rq * gq0[2], q[3] * rq * gq0[3]), pk2(q[4] * rq * gq1[0], q[5] * rq * gq1[1]), pk2(q[6] * rq * gq1[2], q[7] * rq * gq1[3])};
        const float v = bf1(vraw), vp = bf1(vpraw), cs = csn[0], sn = csn[1];
        const float kr = (o & 16) ? vp * sn + v * cs : v * cs - vp * sn;
        KR[(size_t)r * 64 + lane] = (bf16_t)(pk2(kr, 0.f) & 0xffffu);
    }
    for (int r = ML + gw; r < MT; r += nw) {
        const bf16_t* row = CA + (size_t)r * DM;
        const u32x2 kv = *(const u32x2*)(row + 512 + 4 * lane); const bf16_t vraw = row[768 + o];
        const float k0 = bflo(kv[0]), k1 = bfhi(kv[0]), k2 = bflo(kv[1]), k3 = bfhi(kv[1]);
        const float ss = wave_sum(k0 * k0 + k1 * k1 + k2 * k2 + k3 * k3), rstd = rsqrtf(ss * (1.f / 256.f) + 1e-6f);
        *(u32x2*)(CKV + (size_t)r * 256 + 4 * lane) = (u32x2){pk2(k0 * rstd * gkv[0], k1 * rstd * gkv[1]), pk2(k2 * rstd * gkv[2], k3 * rstd * gkv[3])};
        KR[(size_t)r * 64 + lane] = vraw;
    }
}

constexpr int KNB = 0, KRB = 16384, VTB = 24576, ABUF = 40960;
DI void attn_phase(const Ctx& p, LAS unsigned char* lds) {
    const int tid = tid_l(), lane = tid & 63, wv = __builtin_amdgcn_readfirstlane(tid >> 6), ql = lane & 31, hi = lane >> 5;
    const bf16_t* Q = (const bf16_t*)(p.ws + OFF_Q); const bf16_t* KN = (const bf16_t*)(p.ws + OFF_KN); const bf16_t* KR = (const bf16_t*)(p.ws + OFF_KR); const bf16_t* VT = (const bf16_t*)(p.ws + OFF_VT);
    bf16_t* O = (bf16_t*)(p.ws + OFF_O);
    unsigned okn[2], ovt[2], okr;
#pragma unroll
    for (int e = 0; e < 2; ++e) { const int P = (2 * wv + e) * 64 + lane; { const int row = P >> 4, c = (P & 15) ^ (row & 15); okn[e] = (unsigned)(row * 1024 + c * 8); }
        { const int row = P >> 3, c = (P & 7) ^ ((row >> 1) & 7); ovt[e] = (unsigned)(row * NKEY + c * 8); } }
    { const int P = wv * 64 + lane, row = P >> 3, c = (P & 7) ^ ((row >> 1) & 7); okr = (unsigned)(row * 64 + c * 8); }
    const int zk = hi ^ (ql & 15), zr = hi ^ ((ql >> 1) & 7);
    const int rdkn = KNB + ql * 256, rdkr = KRB + ql * 128, rdvt = VTB + ql * 128;
    for (int item = bid_l(); item < 512; item += gridDim.x) {
        const int xcd = item & 7, slot = (item >> 3) & 31, rr = item >> 8, bh = xcd * 2 + (slot >> 4) + 16 * rr, qb = slot & 15, b = bh >> 3, h = bh & 7;
        const int r0 = b * 4096 + qb * 256 + wv * 32 + ql;
        bf16x8 qf[12];
#pragma unroll
        for (int s = 0; s < 12; ++s) qf[s] = *(const bf16x8*)(Q + (size_t)r0 * 1536 + h * 192 + 16 * s + 8 * hi);
        f32x16 oacc[4];
#pragma unroll
        for (int dt = 0; dt < 4; ++dt)
#pragma unroll
            for (int i = 0; i < 16; ++i) oacc[dt][i] = 0.f;
        float mrow = -3.0e38f, lrow = 0.f;
        const bf16_t* vbase = VT + ((size_t)(b * 1024 + h * 128)) * NKEY;
#define ATT_DMA(j, buf) do { const int kb_ = (j) < 4 ? ML + b * 256 + 64 * (j) : b * 4096 + 64 * ((j) - 4); LAS unsigned char* sb_ = lds + (buf) * ABUF; \
            const bf16_t* kn_ = KN + (size_t)kb_ * 1024 + h * 128; const bf16_t* kr_ = KR + (size_t)kb_ * 64; const bf16_t* vt_ = vbase + 64 * (j); \
            __builtin_amdgcn_global_load_lds((const unsigned*)(kn_ + okn[0]), (LAS unsigned*)(sb_ + KNB + (2 * wv) * 1024), 16, 0, 0); \
            __builtin_amdgcn_global_load_lds((const unsigned*)(kn_ + okn[1]), (LAS unsigned*)(sb_ + KNB + (2 * wv + 1) * 1024), 16, 0, 0); \
            __builtin_amdgcn_global_load_lds((const unsigned*)(kr_ + okr), (LAS unsigned*)(sb_ + KRB + wv * 1024), 16, 0, 0); \
            __builtin_amdgcn_global_load_lds((const unsigned*)(vt_ + ovt[0]), (LAS unsigned*)(sb_ + VTB + (2 * wv) * 1024), 16, 0, 0); \
            __builtin_amdgcn_global_load_lds((const unsigned*)(vt_ + ovt[1]), (LAS unsigned*)(sb_ + VTB + (2 * wv + 1) * 1024), 16, 0, 0); } while (0)
        f32x16 s0, s1; bf16x8 pf[2][2];
#define KOFF(s) ((s) < 8 ? rdkn + (((2 * (s)) ^ zk) << 4) : rdkr + (((2 * ((s) - 8)) ^ zr) << 4))
#define KOFF1(s) ((s) < 8 ? 32 * 256 : 32 * 128)
#define VOFF(i) (rdvt + ((i) & 3) * 32 * 128 + (((2 * ((i) >> 2)) ^ zr) << 4))
#define ATT_X(sb) do { _Pragma("unroll") for (int i = 0; i < 16; ++i) { s0[i] = 0.f; s1[i] = 0.f; } \
            bf16x8 ka[3][2]; \
            _Pragma("unroll") for (int s = 0; s < 2; ++s) { ka[s][0] = *(const LAS bf16x8*)((sb) + KOFF(s)); ka[s][1] = *(const LAS bf16x8*)((sb) + KOFF(s) + KOFF1(s)); } \
            _Pragma("unroll") for (int s = 0; s < 12; ++s) { \
                if (s + 2 < 12) { ka[(s + 2) % 3][0] = *(const LAS bf16x8*)((sb) + KOFF(s + 2)); ka[(s + 2) % 3][1] = *(const LAS bf16x8*)((sb) + KOFF(s + 2) + KOFF1(s + 2)); } \
                s0 = __builtin_amdgcn_mfma_f32_32x32x16_bf16(ka[s % 3][0], qf[s], s0, 0, 0, 0); s1 = __builtin_amdgcn_mfma_f32_32x32x16_bf16(ka[s % 3][1], qf[s], s1, 0, 0, 0); \
                __builtin_amdgcn_sched_barrier(0); } } while (0)
#define ATT_Y() do { float mx = s0[0]; \
            _Pragma("unroll") for (int i = 1; i < 16; ++i) mx = fmaxf(mx, s0[i]); \
            _Pragma("unroll") for (int i = 0; i < 16; ++i) mx = fmaxf(mx, s1[i]); \
            { const auto rr_ = __builtin_amdgcn_permlane32_swap(__float_as_uint(mx), __float_as_uint(mx), false, false); mx = fmaxf(__uint_as_float(rr_[0]), __uint_as_float(rr_[1])); }     \
            const float mnew = fmaxf(mrow, mx); \
            if (__builtin_amdgcn_ballot_w64(mnew - mrow > 8.f) != 0ull) { const float alpha = __builtin_amdgcn_exp2f(mrow - mnew); lrow *= alpha; mrow = mnew;     \
                _Pragma("unroll") for (int dt = 0; dt < 4; ++dt) _Pragma("unroll") for (int i = 0; i < 16; ++i) oacc[dt][i] *= alpha; } \
            const float mn = mrow; float ps = 0.f; \
            _Pragma("unroll") for (int i = 0; i < 16; ++i) { s0[i] = __builtin_amdgcn_exp2f(s0[i] - mn); s1[i] = __builtin_amdgcn_exp2f(s1[i] - mn); ps += s0[i] + s1[i]; } \
            lrow += ps; \
            __builtin_amdgcn_sched_barrier(0); \
            _Pragma("unroll") for (int s2 = 0; s2 < 2; ++s2) { \
                pf[0][s2] = __builtin_bit_cast(bf16x8, (u32x4){pk2(s0[8 * s2], s0[8 * s2 + 1]), pk2(s0[8 * s2 + 2], s0[8 * s2 + 3]), pk2(s0[8 * s2 + 4], s0[8 * s2 + 5]), pk2(s0[8 * s2 + 6], s0[8 * s2 + 7])}); \
                pf[1][s2] = __builtin_bit_cast(bf16x8, (u32x4){pk2(s1[8 * s2], s1[8 * s2 + 1]), pk2(s1[8 * s2 + 2], s1[8 * s2 + 3]), pk2(s1[8 * s2 + 4], s1[8 * s2 + 5]), pk2(s1[8 * s2 + 6], s1[8 * s2 + 7])}); } \
            __builtin_amdgcn_sched_barrier(0); } while (0)
#define ATT_Z(sb) do { bf16x8 va[5]; \
            _Pragma("unroll") for (int i = 0; i < 4; ++i) va[i] = *(const LAS bf16x8*)((sb) + VOFF(i)); \
            _Pragma("unroll") for (int i = 0; i < 16; ++i) { if (i + 4 < 16) va[(i + 4) % 5] = *(const LAS bf16x8*)((sb) + VOFF(i + 4)); \
                oacc[i & 3] = __builtin_amdgcn_mfma_f32_32x32x16_bf16(va[i % 5], pf[(i >> 3) & 1][(i >> 2) & 1], oacc[i & 3], 0, 0, 0); __builtin_amdgcn_sched_barrier(0); } } while (0)
#define ATT_SYNC() do { asm volatile("s_waitcnt vmcnt(0)" ::: "memory"); __syncthreads(); } while (0)
        ATT_DMA(0, 0); ATT_DMA(1, 1);
        asm volatile("s_waitcnt vmcnt(5)" ::: "memory"); __syncthreads();
        for (int j = 0; j < NCH; ++j) {
            if (j + 2 < NCH) ATT_DMA(j + 2, (j + 2) % 3);
            LAS unsigned char* sb = lds + (j % 3) * ABUF;
            ATT_X(sb); ATT_Y(); ATT_Z(sb);
            if (j + 2 < NCH) asm volatile("s_waitcnt vmcnt(5)" ::: "memory"); else asm volatile("s_waitcnt vmcnt(0)" ::: "memory");
            __syncthreads();
        }
#undef KOFF
#undef KOFF1
#undef VOFF
#undef ATT_X
#undef ATT_Y
#undef ATT_Z
#undef ATT_SYNC
#undef ATT_DMA
        const float inv = 1.f / (lrow + __shfl_xor(lrow, 32));
#pragma unroll
        for (int dt = 0; dt < 4; ++dt)
#pragma unroll
            for (int rg = 0; rg < 4; ++rg)
                *(u32x2*)(O + (size_t)r0 * DM + h * 128 + 32 * dt + 8 * rg + 4 * hi) = (u32x2){pk2(oacc[dt][4 * rg] * inv, oacc[dt][4 * rg + 1] * inv), pk2(oacc[dt][4 * rg + 2] * inv, oacc[dt][4 * rg + 3] * inv)};
    }
}
struct PD { int kind, sync, M, N, K, lda, ldb, ldo, agrp, rot; unsigned offA, offB, offO; int r[9]; };
enum { K_PRO = 0, K_ROW, K_GSWI, K_GSTORE, K_GRGIN, K_CONV, K_GGATE, K_S1, K_S3, K_MLAN, K_GQ, K_GVT, K_ATT, K_GPART };
#define BIGG (1 << 20)
#define ROWP(first, pl, psub, pg, pw2, hn, nl, nsub, ng, M, convb, nsplit) {K_ROW, 1, M, 0, 0, 0, 0, 0, convb, nsplit, 0u, 0u, 0u, {first, pl, psub, pg, pw2, hn, nl, nsub, ng}}
#define GEMMP(kind, sync, M, N, K, lda, ldb, ldo, agrp, rot, offA, offB, offO) {kind, sync, M, N, K, lda, ldb, ldo, agrp, rot, (unsigned)(offA), (unsigned)(offB), (unsigned)(offO), {0, 0, 0, 0, 0, 0, 0, 0, 0}}
#define MISCP(kind) {kind, 1, 0, 0, 0, 0, 0, 0, 0, 0, 0u, 0u, 0u, {0, 0, 0, 0, 0, 0, 0, 0, 0}}
#define G1P(offW, M) GEMMP(K_GSWI, 1, M, 5632, 1024, 1024, 1024, 2816, BIGG, 0, OFF_XN, offW, OFF_H)
#define G2P(offW, M) GEMMP(K_GSTORE, 1, M, 1024, 2816, 2816, 2816, 1024, BIGG, 0, OFF_H, offW, OFF_Y)
#define G2L(offA, offW, Kf, offO) GEMMP(K_GSTORE, 0, ML, 1024, Kf, Kf, Kf, 1024, BIGG, 0, offA, offW, offO)
#define G2C(offA, offW, Kf) GEMMP(K_GPART, 1, MC, 1024 * (Kf / 256), 256, Kf, Kf, 4, 4, 0, (offA) + (size_t)ML * (Kf) * 2, offW, 0)
constexpr int NPH = 32;
__device__ const PD PROG[NPH] = {
    MISCP(K_PRO),
    ROWP(1, 0, 0, 0, 0, 1, 0, 0, 0, MT, 0, 0),
    G1P(OFF_WIN0, MT), G2L(OFF_H, OFF_WOUT0, 2816, OFF_Y), G2C(OFF_H, OFF_WOUT0, 2816),
    ROWP(0, 0, 0, 1, 1, 1, 0, 1, 2, MT, 0, 11),
    GEMMP(K_GRGIN, 1, MT, 2048, 1024, 1024, 1024, 1024, BIGG, 0, OFF_XN, OFF_RGIN, 0),
    MISCP(K_CONV),
    GEMMP(K_GGATE, 1, MT, 4096, 256, 1024, 256, 0, 4, 0, OFF_UC, OFF_GATE, 0),
    MISCP(K_S1), MISCP(K_S3),
    GEMMP(K_GSTORE, 1, MT, 1024, 1024, 1024, 1024, 1024, BIGG, 0, OFF_YG, OFF_RGOUT, OFF_Y),
    ROWP(0, 0, 1, 3, 2, 1, 0, 2, 4, MT, 1, 0),
    G1P(OFF_WIN0 + SZ_WIN, MT), G2L(OFF_H, OFF_WOUT0 + SZ_WOUT, 2816, OFF_Y), G2C(OFF_H, OFF_WOUT0 + SZ_WOUT, 2816),
    ROWP(0, 0, 2, 5, 1, 1, 1, 0, 0, MT, 0, 11),
    G1P(OFF_WIN1, MT), G2L(OFF_H, OFF_WOUT1, 2816, OFF_Y), G2C(OFF_H, OFF_WOUT1, 2816),
    ROWP(0, 1, 0, 1, 1, 1, 1, 1, 2, MT, 0, 11),
    GEMMP(K_GSTORE, 1, MT, 1024, 1024, 1024, 1024, 1024, BIGG, 0, OFF_XN, OFF_WA, OFF_CA),
    MISCP(K_MLAN),
    GEMMP(K_GQ, 0, ML, 1536, 512, 512, 512, 1536, BIGG, 0, OFF_CQ, OFF_WQB, OFF_Q),
    GEMMP(K_GSTORE, 0, MT, 1024, 256, 256, 256, 1024, BIGG, 128, OFF_CKV, OFF_WKN, OFF_KN),
    GEMMP(K_GVT, 1, 1024, MT, 256, 256, 256, 0, BIGG, 64, OFF_WV, OFF_CKV, OFF_VT),
    MISCP(K_ATT),
    GEMMP(K_GSTORE, 1, ML, 1024, 1024, 1024, 1024, 1024, BIGG, 0, OFF_O, OFF_WO, OFF_Y),
    ROWP(0, 1, 1, 3, 2, 1, 1, 2, 4, ML, 0, 0),
    G1P(OFF_WIN1 + SZ_WIN, ML), G2P(OFF_WOUT1 + SZ_WOUT, ML),
    ROWP(0, 1, 2, 5, 1, 0, 0, 0, 0, ML, 0, 0),
};

template <class Epi> DI void run_gemm(LAS unsigned char* lds, const Ctx& p, const PD& d, const Epi& E) {
    pg8::Gemm g; g.A = (const bf16_t*)(p.ws + d.offA); g.Bt = (const bf16_t*)(p.ws + d.offB); g.M = d.M; g.N = d.N; g.K = d.K; g.lda = d.lda; g.ldb = d.ldb; g.agrp = d.agrp; g.bmod = BIGG;
    pg8::StaticOrder S; S.init(d.M, d.N, (int)gridDim.x, (int)((bid_l() + (unsigned)d.rot) % gridDim.x));
    pg8::gemm_phase<Epi, pg8::StaticOrder, false>(lds, g, S, E, nullptr);
}

__global__ void __launch_bounds__(512, 2) mega_fwd(Params kp) {
    extern __shared__ __attribute__((aligned(16))) unsigned char shm[];
    cg::grid_group grid = cg::this_grid();
    LAS unsigned char* lds = (LAS unsigned char*)shm;
    volatile XLAS unsigned* xst = (volatile XLAS unsigned*)(lds + 131072);
    if (tid_l() == 0) { xst[0] = 0u; xst[1] = 0u; xst[2] = 0u; xst[3] = 0u; }
    __syncthreads();
    const XcdBarrier xb = xcd_barrier_post((unsigned*)(kp.ws + OFF_BAR), xst);
    int ph = kp.ph_lo;
#if defined(PROBE_KIND)
#ifndef PROBE_PH
#define PROBE_PH -1
#endif
    int rep_ = 0;
#endif
#if defined(PROBE_PRO)
    if (ph == 0) { prologue_phase(kp, (float*)shm); __syncthreads(); }
#endif
    if (kp.ph_hi < 0) grid.sync();
    if (ph == 0) { prologue_phase(kp, (float*)shm); ph = 1; if (ph < kp.ph_hi) xcd_barrier(xb); }
    for (; ph < kp.ph_hi; ++ph) {
        Ctx p; { unsigned long long w = (unsigned long long)kp.ws, o = (unsigned long long)kp.out; asm volatile("" : "+s"(w), "+s"(o));
            p.ws = (unsigned char*)(GAS unsigned char*)w; p.out = (float*)(GAS float*)o; p.tab = (const float* const*)(GAS const float* const*)(w + OFF_TAB); }
        const PD& d = PROG[ph];
        switch (d.kind) {
            case K_ROW: { if (d.agrp) { convert_set_b(p, (float*)shm); }
                RowD rd; rd.first = d.r[0]; rd.pl = d.r[1]; rd.psub = d.r[2]; rd.pg = d.r[3]; rd.pw2 = d.r[4]; rd.has_next = d.r[5]; rd.nl = d.r[6]; rd.nsub = d.r[7]; rd.ng = d.r[8]; rd.M = d.M; rd.nsplit = d.rot; row_phase(p, rd); } break;
            case K_GSWI: { EpiSwiglu E; E.H = (bf16_t*)(p.ws + d.offO); run_gemm(lds, p, d, E); } break;
            case K_GSTORE: { EpiStore E; E.O = (bf16_t*)(p.ws + d.offO); E.ldo = d.ldo; run_gemm(lds, p, d, E); } break;
            case K_GPART: { EpiPart E; E.P = (float*)(p.ws + OFF_PART); E.nct = d.ldo; pg8::Gemm g; g.A = (const bf16_t*)(p.ws + d.offA); g.Bt = (const bf16_t*)(p.ws + d.offB); g.M = d.M; g.N = d.N; g.K = d.K; g.lda = d.lda; g.ldb = d.ldb; g.agrp = d.ldo; g.bmod = d.ldo;
                pg8::StaticOrder S; S.init(d.M, d.N, (int)gridDim.x, (int)((bid_l() + 40u) % gridDim.x)); pg8::gemm_phase<EpiPart, pg8::StaticOrder, false>(lds, g, S, E, nullptr); } break;
            case K_GRGIN: { EpiRgIn E; E.YG = (bf16_t*)(p.ws + OFF_YG); E.U = (bf16_t*)(p.ws + OFF_U); run_gemm(lds, p, d, E); } break;
            case K_CONV: conv_phase(p); break;
            case K_GGATE: { EpiGate E; E.UC = (const bf16_t*)(p.ws + OFF_UC); E.gate_b = p.in(I_GATEB); E.lam = p.in(I_LAM); E.AB0 = (__half2*)(p.ws + OFF_AB0); E.AB1 = (__half2*)(p.ws + OFF_AB1); run_gemm(lds, p, d, E); } break;
            case K_S1: scan1_phase(p, lds); break;
            case K_S3: scan3_phase(p, lds); break;
            case K_MLAN: mla_norm_phase(p); break;
            case K_GQ: { EpiQ E; E.Q = (bf16_t*)(p.ws + OFF_Q); E.rope = (const float*)(p.ws + OFF_ROPE); run_gemm(lds, p, d, E); } break;
            case K_GVT: { EpiVT E; E.VT = (bf16_t*)(p.ws + OFF_VT); run_gemm(lds, p, d, E); } break;
            case K_ATT: attn_phase(p, lds); break;
            default: break;
        }
#if defined(PROBE_KIND)
        if ((((PROBE_KIND >> d.kind) & 1) || ph == PROBE_PH) && rep_ < PROBE_REP) { ++rep_; --ph; xcd_barrier(xb); continue; }
        rep_ = 0;
#endif
#if defined(PROBE_SYNC)
        for (int i_ = 0; i_ < PROBE_SYNC; ++i_) xcd_barrier(xb);
#endif
        if (d.sync && ph + 1 < kp.ph_hi) xcd_barrier(xb);
    }
}

extern "C" void kernel_launch(void* const* d_in, const int* in_sizes, int n_in, void* d_out, int out_size, void* d_ws, size_t ws_size, hipStream_t stream) {
    static int grid_blocks = 0;
    if (!grid_blocks) {
        int dev = 0, cus = 0, per_cu = 0;
        (void)hipGetDevice(&dev);
        (void)hipDeviceGetAttribute(&cus, hipDeviceAttributeMultiprocessorCount, dev);
        if (hipFuncSetAttribute((const void*)mega_fwd, hipFuncAttributeMaxDynamicSharedMemorySize, LDS_BYTES + 16) != hipSuccess) { fprintf(stderr, "kernel_launch: hipFuncSetAttribute failed\n"); }
        (void)hipOccupancyMaxActiveBlocksPerMultiprocessor(&per_cu, (const void*)mega_fwd, 512, LDS_BYTES + 16);
        if (per_cu < 1) { fprintf(stderr, "kernel_launch: occupancy query reports %d blocks per CU\n", per_cu); per_cu = 1; }
        grid_blocks = cus;
        (void)hipGetLastError();
    }
    if (n_in != 27 || ws_size < WS_TOTAL) { fprintf(stderr, "kernel_launch: unexpected n_in %d or workspace %zu < %zu\n", n_in, ws_size, (size_t)WS_TOTAL); return; }
    Params p{};
    for (int i = 0; i < 27; ++i) p.inp[i] = (const float*)d_in[i];
    p.out = (float*)d_out; p.ws = (unsigned char*)d_ws; p.ph_lo = 0; p.ph_hi = NPH;
    if (hipMemsetAsync((unsigned char*)d_ws + OFF_BAR, 0, XCD_BAR_WORDS * sizeof(unsigned), stream) != hipSuccess) { fprintf(stderr, "kernel_launch: memset of the barrier words failed\n"); return; }
    void* args[] = {&p};
    hipError_t e = hipLaunchCooperativeKernel((const void*)mega_fwd, dim3(grid_blocks), dim3(512), args, LDS_BYTES + 16, stream);
    if (e != hipSuccess) fprintf(stderr, "kernel_launch: cooperative launch failed: %s (grid %d)\n", hipGetErrorString(e), grid_blocks);
}
```
